# Optimizing an MI355X kernel written in HIP

```python
import math
import jax, jax.numpy as jnp
from jax import lax
import numpy as np

D_MODEL = 1024
BATCH = 4
SEQ = 4096
DEPTH = 2

CHUNK = 64
Q_BLOCK = 128
A_HEADS = 8
A_HEAD_DIM = 64
IDX_HEADS = 4
IDX_DIM = 64
TOPK_MAX = 256
B_HEADS = 4
B_HEAD_DIM = 64
C_HEADS = 8
C_HEAD_DIM = 64
REL_BUCKETS = 32
REL_MAX_DIST = 128
D_FF = 2816
N_EXPERTS = 8
TOP_K_EXPERTS = 2
D_FF_EXPERT = 3584
EPS = 1e-6
SUBLN_EPS = 1e-5

A_WIDTH = A_HEADS * A_HEAD_DIM
B_WIDTH = B_HEADS * 2 * B_HEAD_DIM
C_WIDTH = C_HEADS * C_HEAD_DIM
BRANCH_WIDTHS = (A_WIDTH, B_WIDTH, C_WIDTH)
MIX_WIDTH = A_WIDTH + B_WIDTH + C_WIDTH
N_BRANCHES = 3
IN_SIZES = (A_WIDTH, A_WIDTH, A_WIDTH,
            IDX_HEADS * IDX_DIM, IDX_DIM, IDX_HEADS,
            B_WIDTH, B_WIDTH, B_WIDTH,
            C_WIDTH, C_WIDTH, C_WIDTH,
            N_BRANCHES * D_MODEL)
IN_WIDTH = sum(IN_SIZES)
N_DENSE = (DEPTH + 1) // 2
N_MOE = DEPTH // 2

kernel_name = "hybrid_dsa_diff_stickbreak_moe_block"


def rmsnorm(x, g, eps=EPS):
    x32 = x.astype(jnp.float32)
    y = x32 * lax.rsqrt(jnp.mean(x32 * x32, axis=-1, keepdims=True) + eps)
    return y.astype(x.dtype) * g


def rel_bucket(rel):
    half = REL_BUCKETS // 2
    max_exact = half // 2
    bucket = jnp.where(rel > 0, half, 0)
    n = jnp.abs(rel)
    nf = jnp.maximum(n, 1).astype(jnp.float32)
    large = max_exact + (jnp.log(nf / max_exact) / math.log(REL_MAX_DIST / max_exact)
                         * (half - max_exact)).astype(jnp.int32)
    large = jnp.minimum(large, half - 1)
    return bucket + jnp.where(n < max_exact, n, large)


def dsa_mixer(q, k, v, qi, ki, wi, bias_tab):
    bsz, s_len = q.shape[0], q.shape[1]
    topk = min(TOPK_MAX, s_len // 4)
    n_blk = s_len // CHUNK
    key_pos = jnp.arange(s_len)
    scale = A_HEAD_DIM ** -0.5

    def block(i):
        t0 = i * CHUNK
        qb = lax.dynamic_slice_in_dim(q, t0, CHUNK, axis=1)
        qib = lax.dynamic_slice_in_dim(qi, t0, CHUNK, axis=1)
        wib = lax.dynamic_slice_in_dim(wi, t0, CHUNK, axis=1)
        dots = jnp.einsum('bqhd,bsd->bqhs', qib, ki) * (IDX_DIM ** -0.5)
        score = jnp.einsum('bqh,bqhs->bqs', wib, jax.nn.relu(dots)).astype(jnp.float32)
        limit = t0 + CHUNK
        score = jnp.where((key_pos < limit)[None, None, :], score, -jnp.inf)
        _, sel = lax.top_k(score, topk)
        valid = sel < limit
        k_sel = jax.vmap(lambda kk, ii: kk[ii])(k, sel)
        v_sel = jax.vmap(lambda vv, ii: vv[ii])(v, sel)
        qpos = t0 + jnp.arange(CHUNK)
        bias = bias_tab[rel_bucket(sel - qpos[None, :, None])]
        logits = jnp.einsum('bqhd,bqkhd->bhqk', qb, k_sel).astype(jnp.float32) * scale
        logits = logits + jnp.transpose(bias, (0, 3, 1, 2)).astype(jnp.float32)
        logits = jnp.where(valid[:, None], logits, -jnp.inf)
        p = jax.nn.softmax(logits, axis=-1).astype(v.dtype)
        o = jnp.einsum('bhqk,bqkhd->bqhd', p, v_sel)
        return o.reshape(bsz, CHUNK, A_WIDTH)

    out = lax.map(block, jnp.arange(n_blk))
    return jnp.moveaxis(out, 0, 1).reshape(bsz, s_len, A_WIDTH)


def diff_mixer(q, k, v, lam, lam_init, subln_g, bias_tab):
    bsz, s_len = q.shape[0], q.shape[1]
    n_blk = s_len // Q_BLOCK
    key_pos = jnp.arange(s_len)
    scale = B_HEAD_DIM ** -0.5

    def block(i):
        t0 = i * Q_BLOCK
        qb = lax.dynamic_slice_in_dim(q, t0, Q_BLOCK, axis=1)
        qpos = t0 + jnp.arange(Q_BLOCK)
        logits = jnp.einsum('bqhmd,bshmd->bhmqs', qb, k).astype(jnp.float32) * scale
        bias = bias_tab[rel_bucket(key_pos[None, :] - qpos[:, None])]
        bias = jnp.transpose(bias, (2, 0, 1)).astype(jnp.float32)
        mask = (key_pos[None, :] // CHUNK) <= (qpos[:, None] // CHUNK)
        logits = jnp.where(mask, logits + bias[None, :, None], -jnp.inf)
        p = jax.nn.softmax(logits, axis=-1)
        attn = (p[:, :, 0] - lam * p[:, :, 1]).astype(v.dtype)
        o = jnp.einsum('bhqs,bshe->bqhe', attn, v)
        o = rmsnorm(o, subln_g, SUBLN_EPS) * (1.0 - lam_init)
        return o.reshape(bsz, Q_BLOCK, B_WIDTH)

    out = lax.map(block, jnp.arange(n_blk))
    return jnp.moveaxis(out, 0, 1).reshape(bsz, s_len, B_WIDTH)


def stickbreak_mixer(q, k, v):
    bsz, s_len = q.shape[0], q.shape[1]
    n_blk = s_len // Q_BLOCK
    key_pos = jnp.arange(s_len)
    scale = C_HEAD_DIM ** -0.5

    def block(i):
        t0 = i * Q_BLOCK
        qb = lax.dynamic_slice_in_dim(q, t0, Q_BLOCK, axis=1)
        qpos = t0 + jnp.arange(Q_BLOCK)
        z = jnp.einsum('bqhd,bshd->bhqs', qb, k).astype(jnp.float32) * scale
        strict = key_pos[None, :] < qpos[:, None]
        log_1mb = jnp.where(strict, jax.nn.log_sigmoid(-z), 0.0)
        between = lax.cumsum(log_1mb, axis=3, reverse=True) - log_1mb
        w = jnp.where(strict, jnp.exp(jax.nn.log_sigmoid(z) + between), 0.0)
        o = jnp.einsum('bhqs,bshd->bqhd', w.astype(v.dtype), v)
        return o.reshape(bsz, Q_BLOCK, C_WIDTH)

    out = lax.map(block, jnp.arange(n_blk))
    return jnp.moveaxis(out, 0, 1).reshape(bsz, s_len, C_WIDTH)


def swiglu(h, w1, w3, w2):
    return (jax.nn.silu(h @ w1) * (h @ w3)) @ w2


def moe_swiglu(h, w_r, b_r, w1, w3, w2):
    logits = (h @ w_r).astype(jnp.float32) + b_r
    top_val, top_idx = lax.top_k(logits, TOP_K_EXPERTS)
    top_w = jax.nn.softmax(top_val, axis=-1)
    combine = jnp.sum(jax.nn.one_hot(top_idx, N_EXPERTS, dtype=jnp.float32)
                      * top_w[..., None], axis=-2).astype(h.dtype)
    out = jnp.zeros_like(h)
    for e in range(N_EXPERTS):
        out = out + combine[..., e:e + 1] * swiglu(h, w1[e], w3[e], w2[e])
    return out


def setup_inputs(seed: int = 0) -> dict:
    key = jax.random.key(seed)
    ks = jax.random.split(key, 24)
    nrm = jax.random.normal
    f32 = jnp.float32
    w_br = jnp.concatenate(
        [nrm(ks[7 + j], (DEPTH, w, D_MODEL), f32) * w ** -0.5 for j, w in enumerate(BRANCH_WIDTHS)],
        axis=1)
    return {
        "x": nrm(ks[0], (BATCH, SEQ, D_MODEL), f32),
        "c": nrm(ks[1], (BATCH, D_MODEL), f32),
        "w_ada": nrm(ks[2], (DEPTH, D_MODEL, 6 * D_MODEL), f32) * 0.5 * D_MODEL ** -0.5,
        "b_ada": nrm(ks[3], (DEPTH, 6 * D_MODEL), f32) * 0.02,
        "norm1_g": 1.0 + 0.02 * nrm(ks[4], (DEPTH, D_MODEL), f32),
        "norm2_g": 1.0 + 0.02 * nrm(ks[5], (DEPTH, D_MODEL), f32),
        "w_in": nrm(ks[6], (DEPTH, D_MODEL, IN_WIDTH), f32) * D_MODEL ** -0.5,
        "w_br": w_br,
        "w_out": nrm(ks[10], (DEPTH, D_MODEL, D_MODEL), f32) * D_MODEL ** -0.5,
        "rel_bias": nrm(ks[11], (REL_BUCKETS, A_HEADS + B_HEADS), f32) * 0.5,
        "lam_params": nrm(ks[12], (DEPTH, 4, B_HEAD_DIM), f32) * 0.1,
        "subln_g": 1.0 + 0.02 * nrm(ks[13], (DEPTH, 2 * B_HEAD_DIM), f32),
        "ffn_w1": nrm(ks[14], (N_DENSE, D_MODEL, D_FF), f32) * D_MODEL ** -0.5,
        "ffn_w3": nrm(ks[15], (N_DENSE, D_MODEL, D_FF), f32) * D_MODEL ** -0.5,
        "ffn_w2": nrm(ks[16], (N_DENSE, D_FF, D_MODEL), f32) * D_FF ** -0.5,
        "router_w": nrm(ks[17], (N_MOE, D_MODEL, N_EXPERTS), f32) * D_MODEL ** -0.5,
        "router_b": nrm(ks[18], (N_MOE, N_EXPERTS), f32) * 0.01,
        "moe_w1": nrm(ks[19], (N_MOE, N_EXPERTS, D_MODEL, D_FF_EXPERT), f32) * D_MODEL ** -0.5,
        "moe_w3": nrm(ks[20], (N_MOE, N_EXPERTS, D_MODEL, D_FF_EXPERT), f32) * D_MODEL ** -0.5,
        "moe_w2": nrm(ks[21], (N_MOE, N_EXPERTS, D_FF_EXPERT, D_MODEL), f32) * D_FF_EXPERT ** -0.5,
        "final_g": 1.0 + 0.02 * nrm(ks[22], (D_MODEL,), f32),
    }


def reference(x, c, w_ada, b_ada, norm1_g, norm2_g, w_in, w_br, w_out, rel_bias,
              lam_params, subln_g, ffn_w1, ffn_w3, ffn_w2, router_w, router_b,
              moe_w1, moe_w3, moe_w2, final_g):
    bsz, s_len = x.shape[0], x.shape[1]
    in_offsets = [int(o) for o in np.cumsum(IN_SIZES)[:-1]]
    br_offsets = [int(o) for o in np.cumsum(BRANCH_WIDTHS)[:-1]]
    bias_a = rel_bias[:, :A_HEADS]
    bias_b = rel_bias[:, A_HEADS:]
    for l in range(DEPTH):
        mod = jax.nn.silu(c) @ w_ada[l] + b_ada[l]
        sh1, sc1, g1, sh2, sc2, g2 = jnp.split(mod[:, None, :], 6, axis=-1)
        h = rmsnorm(x, norm1_g[l]) * (1.0 + sc1) + sh1
        parts = jnp.split(h @ w_in[l], in_offsets, axis=-1)
        (qa, ka, va, qi, ki, wi, qb, kb, vb, qc, kc, vc, gl) = parts
        o_a = dsa_mixer(qa.reshape(bsz, s_len, A_HEADS, A_HEAD_DIM),
                        ka.reshape(bsz, s_len, A_HEADS, A_HEAD_DIM),
                        va.reshape(bsz, s_len, A_HEADS, A_HEAD_DIM),
                        qi.reshape(bsz, s_len, IDX_HEADS, IDX_DIM), ki,
                        wi * IDX_HEADS ** -0.5, bias_a)
        lam_init = 0.8 - 0.6 * math.exp(-0.3 * l)
        lp = lam_params[l].astype(jnp.float32)
        lam = jnp.exp(jnp.sum(lp[0] * lp[1])) - jnp.exp(jnp.sum(lp[2] * lp[3])) + lam_init
        o_b = diff_mixer(qb.reshape(bsz, s_len, B_HEADS, 2, B_HEAD_DIM),
                         kb.reshape(bsz, s_len, B_HEADS, 2, B_HEAD_DIM),
                         vb.reshape(bsz, s_len, B_HEADS, 2 * B_HEAD_DIM),
                         lam, lam_init, subln_g[l], bias_b)
        o_c = stickbreak_mixer(qc.reshape(bsz, s_len, C_HEADS, C_HEAD_DIM),
                               kc.reshape(bsz, s_len, C_HEADS, C_HEAD_DIM),
                               vc.reshape(bsz, s_len, C_HEADS, C_HEAD_DIM))
        gates = jax.nn.sigmoid(gl.reshape(bsz, s_len, N_BRANCHES, D_MODEL))
        w_rows = jnp.split(w_br[l], br_offsets, axis=0)
        merged = (gates[:, :, 0] * (o_a @ w_rows[0])
                  + gates[:, :, 1] * (o_b @ w_rows[1])
                  + gates[:, :, 2] * (o_c @ w_rows[2]))
        x = x + g1 * (merged @ w_out[l])
        h2 = rmsnorm(x, norm2_g[l]) * (1.0 + sc2) + sh2
        j = l // 2
        if l % 2 == 0:
            f = swiglu(h2, ffn_w1[j], ffn_w3[j], ffn_w2[j])
        else:
            f = moe_swiglu(h2, router_w[j], router_b[j], moe_w1[j], moe_w3[j], moe_w2[j])
        x = x + g2 * f
    return rmsnorm(x, final_g)
```

```cpp
#include <hip/hip_runtime.h>
#include <cstdio>
#include <cstdint>

#define LAS __attribute__((address_space(3)))
#define GAS __attribute__((address_space(1)))
typedef unsigned short bf16_t;
typedef short bf16x8 __attribute__((ext_vector_type(8)));
typedef float f32x2 __attribute__((ext_vector_type(2)));
typedef float f32x4 __attribute__((ext_vector_type(4)));
typedef float f32x16 __attribute__((ext_vector_type(16)));
typedef unsigned u32x2 __attribute__((ext_vector_type(2)));
typedef unsigned u32x4 __attribute__((ext_vector_type(4)));
typedef __bf16 bf16x2_t __attribute__((ext_vector_type(2)));

__device__ __forceinline__ unsigned cvtpk(float lo, float hi) { f32x2 v = {lo, hi}; bf16x2_t b = __builtin_convertvector(v, bf16x2_t); return __builtin_bit_cast(unsigned, b); }
__device__ __forceinline__ float bf_lo(unsigned w) { return __uint_as_float(w << 16); }
__device__ __forceinline__ float bf_hi(unsigned w) { return __uint_as_float(w & 0xffff0000u); }
__device__ __forceinline__ float fexp2(float x) { return __builtin_amdgcn_exp2f(x); }
__device__ __forceinline__ float flog2(float x) { return __builtin_amdgcn_logf(x); }
__device__ __forceinline__ float frcp(float x) { return __builtin_amdgcn_rcpf(x); }
__device__ __forceinline__ float wave_sum(float v) {
#pragma unroll
    for (int o = 1; o < 64; o <<= 1) v += __shfl_xor(v, o);
    return v;
}
__device__ __forceinline__ int wave_sum_i32(int v) {
    v += __builtin_amdgcn_update_dpp(0, v, 0x111, 0xf, 0xf, false);
    v += __builtin_amdgcn_update_dpp(0, v, 0x112, 0xf, 0xf, false);
    v += __builtin_amdgcn_update_dpp(0, v, 0x114, 0xf, 0xf, false);
    v += __builtin_amdgcn_update_dpp(0, v, 0x118, 0xf, 0xf, false);
    v += __builtin_amdgcn_update_dpp(0, v, 0x142, 0xa, 0xf, false);
    v += __builtin_amdgcn_update_dpp(0, v, 0x143, 0xc, 0xf, false);
    return __builtin_amdgcn_readlane(v, 63);
}
__device__ __forceinline__ unsigned wave_max_u32(unsigned v) {
#define WMX_(ctrl, rm) v = max(v, (unsigned)__builtin_amdgcn_update_dpp(0, (int)v, ctrl, rm, 0xf, false))
    WMX_(0x111, 0xf); WMX_(0x112, 0xf); WMX_(0x114, 0xf); WMX_(0x118, 0xf); WMX_(0x142, 0xa); WMX_(0x143, 0xc);
#undef WMX_
    return (unsigned)__builtin_amdgcn_readlane((int)v, 63);
}
__device__ __forceinline__ unsigned wave_min_u32(unsigned v) {
#define WMN_(ctrl, rm) v = min(v, (unsigned)__builtin_amdgcn_update_dpp(-1, (int)v, ctrl, rm, 0xf, false))
    WMN_(0x111, 0xf); WMN_(0x112, 0xf); WMN_(0x114, 0xf); WMN_(0x118, 0xf); WMN_(0x142, 0xa); WMN_(0x143, 0xc);
#undef WMN_
    return (unsigned)__builtin_amdgcn_readlane((int)v, 63);
}
__device__ __forceinline__ int wave_scan_i32(int v) {
    v += __builtin_amdgcn_update_dpp(0, v, 0x111, 0xf, 0xf, false);
    v += __builtin_amdgcn_update_dpp(0, v, 0x112, 0xf, 0xf, false);
    v += __builtin_amdgcn_update_dpp(0, v, 0x114, 0xf, 0xf, false);
    v += __builtin_amdgcn_update_dpp(0, v, 0x118, 0xf, 0xf, false);
    v += __builtin_amdgcn_update_dpp(0, v, 0x142, 0xa, 0xf, false);
    v += __builtin_amdgcn_update_dpp(0, v, 0x143, 0xc, 0xf, false);
    return v;
}
__device__ __forceinline__ int otid() { int t = threadIdx.x; asm volatile("" : "+v"(t)); return t; }
__device__ __forceinline__ float xhalf(float v) {
    auto rr = __builtin_amdgcn_permlane32_swap(__float_as_uint(v), __float_as_uint(v), false, false);
    return (threadIdx.x & 32) ? __uint_as_float(rr[0]) : __uint_as_float(rr[1]);
}

namespace pg8 {
constexpr int BM = 256, BK = 64, HALF = 128, HTB = HALF * BK * 2, STAGE_BYTES = 8 * HTB, NXCD = 8, WGM = 8;
__host__ __device__ __forceinline__ int lds_byte(int r, int c) { const int st = (r >> 4) * 2 + (c >> 5), rr = r & 15, cc = c & 31, ob = rr * 64 + cc * 2; return st * 1024 + (ob ^ (((ob >> 9) & 1) << 5)); }
__host__ __device__ __forceinline__ void stage_rc(int b, int& R, int& C) { const int st = b / 1024, sb = b % 1024, swz = sb ^ (((sb >> 9) & 1) << 5); R = (st >> 1) * 16 + swz / 64; C = (st & 1) * 32 + (swz % 64) / 2; }
__host__ __device__ __forceinline__ int perm32(int rho) { const int n = rho >> 4, i = rho & 15; return 8 * (i >> 2) + 4 * n + (i & 3); }

struct Unit { int pm, pn, aux; unsigned a, b; int nt; };
struct Gemm { int K, lda, ldb; };

constexpr int UT_OFF = 132096;
struct UnitTab {
    const LAS u32x4* ut;
    __device__ __forceinline__ bool next(int i, Unit& u) const {
        const u32x4 e = ut[i];
        const unsigned w = __builtin_amdgcn_readfirstlane(e.w);
        if (w == 0u) return false;
        u.nt = (int)(w & 0xffffu);
        u.a = __builtin_amdgcn_readfirstlane(e.x); u.b = __builtin_amdgcn_readfirstlane(e.y);
        const unsigned z = __builtin_amdgcn_readfirstlane(e.z); u.pm = z & 4095; u.pn = (z >> 12) & 4095; u.aux = z >> 24; return true;
    }
};
template <class Epi, bool VARK = false, bool ABLK = false>
__device__ __forceinline__ void gemm_phase(LAS unsigned char* lds, const char* base, const Gemm g, const Epi& E) {
    UnitTab S; S.ut = (const LAS u32x4*)(lds + UT_OFF);
    const int tid = otid(), wid = __builtin_amdgcn_readfirstlane(tid >> 6), lane = tid & 63, wr = wid >> 2, wc = wid & 3, fr = lane & 15, fq = lane >> 4;
    const int K = g.K, nt = K / BK;
    unsigned voffA[2], voffB[2];
#pragma unroll
    for (int i = 0; i < 2; ++i) { int R, C; stage_rc(tid * 16 + i * 8192, R, C); const int Rb = 64 * (R >> 5) + (Epi::PERM ? perm32(R & 31) : (R & 31));
        voffA[i] = ABLK ? (unsigned)((C >> 5) * 16384 + R * 64 + (C & 31) * 2) : (unsigned)(R * g.lda + C) * 2u; voffB[i] = (unsigned)(Rb * g.ldb + C) * 2u; }
    const size_t kstep = (size_t)(BK * 2), kstepA = ABLK ? (size_t)32768 : kstep;
    const unsigned hstepA = ABLK ? (unsigned)HALF * 64u : (unsigned)HALF * g.lda * 2, hstepB = 32u * g.ldb * 2;
    const unsigned ldsw = (unsigned)wid * 1024u;
    const int aoff = lds_byte(wr * 64 + fr, fq * 8), boff = lds_byte(wc * 32 + fr, fq * 8);
#define PG8_SA(b, h) (((b) * 2 + (h)) * HTB)
#define PG8_SB(b, h) ((4 + (b) * 2 + (h)) * HTB)
#define PG8_STAGE(bufoff, gbase, voff) do { _Pragma("unroll") for (int _i = 0; _i < 2; ++_i) \
        __builtin_amdgcn_global_load_lds((const unsigned*)((const char*)(gbase) + (voff)[_i]), (LAS unsigned*)(lds + (bufoff) + ldsw + _i * 8192), 16, 0, 0); } while (0)
#define PG8_LDA(dst, b, h) do { _Pragma("unroll") for (int m = 0; m < 4; ++m) _Pragma("unroll") for (int k = 0; k < 2; ++k) dst[m][k] = *(const LAS bf16x8*)(lds + PG8_SA(b, h) + aoff + m * 2048 + k * 1024); } while (0)
#define PG8_LDB(dst, b, h) do { _Pragma("unroll") for (int n = 0; n < 2; ++n) _Pragma("unroll") for (int k = 0; k < 2; ++k) dst[n][k] = *(const LAS bf16x8*)(lds + PG8_SB(b, h) + boff + n * 2048 + k * 1024); } while (0)
#define PG8_MMA(ai, bj, At, Bt) do { __builtin_amdgcn_s_setprio(1); _Pragma("unroll") for (int m = 0; m < 4; ++m) _Pragma("unroll") for (int n = 0; n < 2; ++n) _Pragma("unroll") for (int k = 0; k < 2; ++k) \
        acc[ai][bj][m][n] = __builtin_amdgcn_mfma_f32_16x16x32_bf16(Bt[n][k], At[m][k], acc[ai][bj][m][n], 0, 0, 0); __builtin_amdgcn_s_setprio(0); } while (0)
#define PG8_WAIT_V(n) asm volatile("s_waitcnt vmcnt(" #n ")" ::: "memory")
#define PG8_WAIT_L(n) asm volatile("s_waitcnt lgkmcnt(" #n ")" ::: "memory")
#define PG8_BAR __builtin_amdgcn_s_barrier()
#define PG8_SCHED __builtin_amdgcn_sched_barrier(0)
    Unit cur, nxt; int ui = 0;
    if (!S.next(0, cur)) return;
    f32x4 acc[2][2][4][2];
#pragma unroll
    for (int a = 0; a < 2; ++a)
#pragma unroll
        for (int b = 0; b < 2; ++b)
#pragma unroll
            for (int m = 0; m < 4; ++m)
#pragma unroll
                for (int n = 0; n < 2; ++n) acc[a][b][m][n] = (f32x4){0.f, 0.f, 0.f, 0.f};
    bf16x8 At[4][2], B0[2][2], B1[2][2];
    const char* cA = base + cur.a; const char* cB = base + cur.b;
    PG8_STAGE(PG8_SB(0, 0), cB, voffB); PG8_STAGE(PG8_SB(0, 1), cB + hstepB, voffB); PG8_STAGE(PG8_SA(0, 0), cA, voffA); PG8_STAGE(PG8_SA(0, 1), cA + hstepA, voffA);
    if (wr == 1) PG8_BAR;
    PG8_WAIT_V(2); PG8_BAR;
    PG8_STAGE(PG8_SB(1, 0), cB + kstep, voffB); PG8_STAGE(PG8_SA(1, 0), cA + kstepA, voffA); PG8_STAGE(PG8_SB(1, 1), cB + hstepB + kstep, voffB);
    PG8_WAIT_V(6); PG8_BAR;
    for (;;) {
        const bool has_next = S.next(ui + 1, nxt);
        const char* nA = has_next ? base + nxt.a : cA; const char* nB = has_next ? base + nxt.b : cB;
        const int ntu = VARK ? cur.nt : nt;
        for (int t = 0; t < ntu; t += 2) {
            const bool last = (t == ntu - 2);
            const char* a1 = cA + (size_t)(t + 1) * kstepA;
            const char* a2 = last ? nA : cA + (size_t)(t + 2) * kstepA; const char* b2 = last ? nB : cB + (size_t)(t + 2) * kstep;
            const char* a3 = a2 + kstepA; const char* b3 = b2 + kstep;
            PG8_LDB(B0, 0, 0); PG8_LDB(B1, 0, 1); PG8_SCHED; PG8_LDA(At, 0, 0); PG8_STAGE(PG8_SA(1, 1), a1 + hstepA, voffA);
            PG8_WAIT_V(8); PG8_WAIT_L(0); PG8_BAR; PG8_MMA(0, 0, At, B0); PG8_MMA(0, 1, At, B1); PG8_BAR; PG8_SCHED;
            PG8_LDA(At, 0, 1); PG8_STAGE(PG8_SB(0, 0), b2, voffB); PG8_STAGE(PG8_SB(0, 1), b2 + hstepB, voffB); PG8_STAGE(PG8_SA(0, 0), a2, voffA);
            PG8_WAIT_V(8); PG8_WAIT_L(0); PG8_BAR; PG8_MMA(1, 0, At, B0); PG8_MMA(1, 1, At, B1); PG8_BAR; PG8_SCHED;
            PG8_LDB(B0, 1, 0); PG8_LDB(B1, 1, 1); PG8_SCHED; PG8_LDA(At, 1, 0); PG8_STAGE(PG8_SA(0, 1), a2 + hstepA, voffA);
            PG8_WAIT_V(8); PG8_WAIT_L(0); PG8_BAR; PG8_MMA(0, 0, At, B0); PG8_MMA(0, 1, At, B1); PG8_BAR; PG8_SCHED;
            PG8_LDA(At, 1, 1); PG8_STAGE(PG8_SB(1, 0), b3, voffB); PG8_STAGE(PG8_SB(1, 1), b3 + hstepB, voffB); PG8_STAGE(PG8_SA(1, 0), a3, voffA);
            PG8_WAIT_V(8); PG8_WAIT_L(0); PG8_BAR; PG8_MMA(1, 0, At, B0); PG8_MMA(1, 1, At, B1); PG8_BAR; PG8_SCHED;
        }
        if (wr == 0) PG8_BAR;
        const bool keep = E(acc, cur, wr, wc, fr, fq);
        if (!has_next) break;
        if (!keep) {
#pragma unroll
        for (int a = 0; a < 2; ++a)
#pragma unroll
            for (int b = 0; b < 2; ++b)
#pragma unroll
                for (int m = 0; m < 4; ++m)
#pragma unroll
                    for (int n = 0; n < 2; ++n) acc[a][b][m][n] = (f32x4){0.f, 0.f, 0.f, 0.f};
        }
        cur = nxt; cA = nA; cB = nB; ++ui;
        if (wr == 1) PG8_BAR;
    }
    PG8_WAIT_V(0);
    PG8_BAR;
#undef PG8_SA
#undef PG8_SB
#undef PG8_STAGE
#undef PG8_LDA
#undef PG8_LDB
#undef PG8_MMA
#undef PG8_WAIT_V
#undef PG8_WAIT_L
#undef PG8_BAR
#undef PG8_SCHED
}
}

#define XB_TMO      128
#define XB_XCNT(j)  (256  + 64 * (j))
#define XB_XSUB(j)  (1280 + 64 * (j))
#define XB_XGEN(j)  (2304 + 64 * (j))
#define XB_TOP      3328
#define XB_TOPGEN   3392
#define XCD_BAR_WORDS 3456
#define XB_SPIN_CAP (1u << 18)
__device__ __forceinline__ unsigned xb_ld(unsigned* p)              { return __hip_atomic_load(p, __ATOMIC_RELAXED, __HIP_MEMORY_SCOPE_AGENT); }
__device__ __forceinline__ unsigned xb_add(unsigned* p, unsigned v) { asm volatile("" : "+v"(v)); return __hip_atomic_fetch_add(p, v, __ATOMIC_RELAXED, __HIP_MEMORY_SCOPE_AGENT); }
__device__ __forceinline__ unsigned xb_xcc_id() { return (unsigned)__builtin_amdgcn_s_getreg((3 << 11) | 20) & 0xFu; }
#define XB_SPIN(cond, bar) do { unsigned _sp = 0; while (cond) { __builtin_amdgcn_s_sleep(1); \
    if ((++_sp & 255u) == 0u) { if (xb_ld(&(bar)[XB_TMO])) break; if (_sp > XB_SPIN_CAP) { (void)xb_add(&(bar)[XB_TMO], 1u); break; } } } } while (0)
struct XcdBarrier { unsigned* bar; unsigned x; volatile LAS unsigned* st; };
__device__ __forceinline__ XcdBarrier xcd_barrier_post(unsigned* bar, volatile LAS unsigned* st) {
    XcdBarrier b; b.bar = bar; b.x = xb_xcc_id(); b.st = st;
    if (threadIdx.x == 0) (void)xb_add(&bar[XB_XCNT(b.x)], 1u);
    return b;
}
__device__ __forceinline__ void xcd_barrier_complete(unsigned* bar, unsigned x, unsigned& nloc, unsigned& nx) {
    const unsigned G = gridDim.x * gridDim.y * gridDim.z;
    unsigned sum, cnt, mine, sp = 0u;
    for (;;) {
        sum = 0u; cnt = 0u; mine = 0u;
#pragma unroll 1
        for (unsigned j = 0; j < 16; ++j) { const unsigned c = xb_ld(&bar[XB_XCNT(j)]); sum += c; cnt += (c > 0u) ? 1u : 0u; mine = (j == x) ? c : mine; }
        if (sum == G) break;
        __builtin_amdgcn_s_sleep(1);
        if ((++sp & 255u) == 0u) { if (xb_ld(&bar[XB_TMO])) break; if (sp > XB_SPIN_CAP) { (void)xb_add(&bar[XB_TMO], 1u); break; } }
    }
    nloc = mine > 0u ? mine : 1u; nx = cnt > 0u ? cnt : 1u;
}
__device__ __forceinline__ void xcd_barrier(const XcdBarrier& b) {
    asm volatile("s_waitcnt vmcnt(0)" ::: "memory");
    __syncthreads();
    if (threadIdx.x == 0) {
        unsigned* bar = b.bar; asm volatile("" : "+s"(bar));
        __builtin_amdgcn_s_waitcnt(0);
        unsigned nloc = b.st[0], nx = b.st[1];
        if (nloc == 0u) { xcd_barrier_complete(bar, b.x, nloc, nx); b.st[0] = nloc; b.st[1] = nx; }
        const unsigned old = xb_add(&bar[XB_XSUB(b.x)], 1u);
        const unsigned gen = old / nloc;
        if (old + 1u == (gen + 1u) * nloc) {
            __builtin_amdgcn_fence(__ATOMIC_RELEASE, "agent");
            asm volatile("s_waitcnt vmcnt(0)" ::: "memory");
            const unsigned og = xb_add(&bar[XB_TOP], 1u);
            const unsigned tg = og / nx;
            if (og + 1u == (tg + 1u) * nx) xb_add(&bar[XB_TOPGEN], 1u);
            else XB_SPIN(xb_ld(&bar[XB_TOPGEN]) == tg, bar);
            __builtin_amdgcn_fence(__ATOMIC_ACQUIRE, "agent");
            xb_add(&bar[XB_XGEN(b.x)], 1u);
            asm volatile("s_waitcnt vmcnt(0)" ::: "memory");
        } else {
            XB_SPIN(xb_ld(&bar[XB_XGEN(b.x)]) == gen, bar);
            __builtin_amdgcn_fence(__ATOMIC_ACQUIRE, "agent");
            asm volatile("s_waitcnt vmcnt(0)" ::: "memory");
        }
    }
    __syncthreads();
}

constexpr int BATCH = 4, SEQ = 4096, T = BATCH * SEQ, D = 1024, DEPTH = 2;
constexpr int NPROJ = 6656;
constexpr int NP = 6784;
constexpr int VTP = T + 128;
constexpr int C_QA = 0, C_KA = 512, C_QB = 1024, C_KB = 1536, C_QC = 2048, C_KC = 2560, C_GATE = 3072, C_QI = 6144, C_KI = 6400, C_WI = 6464;
constexpr int DFF = 2816, DFFE = 3584, NE = 8;
constexpr int XP_ROWS = 2 * T + 2048;
constexpr float LOG2E = 1.4426950408889634f;
constexpr float C2 = 0.125f * LOG2E;
constexpr int NWAVES = 8, NTHREADS = 512;

constexpr size_t MiB = 1u << 20;
constexpr size_t WS_CTL = 0, CTL_ZERO_BYTES = 64 * 1024;
constexpr size_t WS_MOD = 1 * MiB;
constexpr size_t WS_RTE = 1 * MiB + 256 * 1024;
constexpr size_t WS_RTW = WS_RTE + 64 * 1024;
constexpr size_t WS_POS = WS_RTW + 128 * 1024;
constexpr size_t WS_WGCNT = WS_POS + 128 * 1024;
constexpr size_t WS_TILETAB = WS_WGCNT + 8 * 1024;
constexpr size_t WS_MW13 = 3 * MiB, WS_MW2 = 115 * MiB;
constexpr size_t WS_WIN = 171 * MiB, WS_WV = WS_WIN + 26 * MiB, WS_WBR = WS_WV + 6 * MiB, WS_WOUT = WS_WBR + 6 * MiB, WS_W13 = WS_WOUT + 4 * MiB, WS_W2 = WS_W13 + 11 * MiB;
constexpr size_t WS_OC = WS_W2 + 6 * MiB;
constexpr size_t WS_MASK = WS_OC + 16 * MiB;
constexpr size_t WS_WI = WS_MASK + 8 * MiB;
constexpr size_t WS_XP = WS_WIN;
constexpr size_t WS_XN = 256 * MiB;
constexpr size_t WS_OA = WS_XN, WS_OB = WS_XN + 16 * MiB;
constexpr size_t WS_PROJ = 288 * MiB;
constexpr size_t WS_VT = WS_PROJ + 212 * MiB;
constexpr size_t WS_MERGED = WS_VT;
constexpr size_t WS_HID = WS_PROJ;
constexpr size_t WS_END = WS_VT + 49 * MiB;
static_assert(WS_WI + 256 * 1024 <= WS_XN && WS_XP + (size_t)XP_ROWS * 2048 <= WS_XN, "ws map");
static_assert(WS_HID + (size_t)XP_ROWS * DFFE * 2 <= WS_END && WS_PROJ + (size_t)T * NP * 2 <= WS_VT && WS_VT + (size_t)1536 * VTP * 2 <= WS_END, "ws map hid");
constexpr int CW_TMO = 0, CW_BAR = 1024;

struct Seg { int in_idx; long long src_off; int ldw, K, ncols; unsigned long long dst; int row0, blk, stride, item0; };
constexpr int NSEG = 61, SEG_ITEMS = 28928;
__device__ const Seg g_segs[NSEG] = {
{6, 0, 8004, 1024, 512, 179306496ull, 0, 1073741824, 0, 0},
{6, 512, 8004, 1024, 512, 179306496ull, 512, 1073741824, 0, 128},
{6, 1024, 8004, 1024, 512, 206569472ull, 0, 1073741824, 0, 256},
{6, 1536, 8004, 1024, 256, 179306496ull, 6144, 1073741824, 0, 384},
{6, 1792, 8004, 1024, 64, 179306496ull, 6400, 1073741824, 0, 448},
{6, 1856, 8004, 1024, 4, 179306496ull, 6464, 1073741824, 0, 464},
{6, 1860, 8004, 1024, 512, 179306496ull, 1024, 1073741824, 0, 480},
{6, 2372, 8004, 1024, 512, 179306496ull, 1536, 1073741824, 0, 608},
{6, 2884, 8004, 1024, 512, 206569472ull, 512, 1073741824, 0, 736},
{6, 3396, 8004, 1024, 512, 179306496ull, 2048, 1073741824, 0, 864},
{6, 3908, 8004, 1024, 512, 179306496ull, 2560, 1073741824, 0, 992},
{6, 4420, 8004, 1024, 512, 206569472ull, 1024, 1073741824, 0, 1120},
{6, 4932, 8004, 1024, 3072, 179306496ull, 3072, 1073741824, 0, 1248},
{7, 0, 1024, 512, 1024, 212860928ull, 0, 1073741824, 0, 2016},
{7, 524288, 1024, 512, 1024, 213909504ull, 0, 1073741824, 0, 2144},
{7, 1048576, 1024, 512, 1024, 214958080ull, 0, 1073741824, 0, 2272},
{8, 0, 1024, 1024, 1024, 219152384ull, 0, 1073741824, 0, 2400},
{6, 8196096, 8004, 1024, 512, 192937984ull, 0, 1073741824, 0, 2656},
{6, 8196608, 8004, 1024, 512, 192937984ull, 512, 1073741824, 0, 2784},
{6, 8197120, 8004, 1024, 512, 209715200ull, 0, 1073741824, 0, 2912},
{6, 8197632, 8004, 1024, 256, 192937984ull, 6144, 1073741824, 0, 3040},
{6, 8197888, 8004, 1024, 64, 192937984ull, 6400, 1073741824, 0, 3104},
{6, 8197952, 8004, 1024, 4, 192937984ull, 6464, 1073741824, 0, 3120},
{6, 8197956, 8004, 1024, 512, 192937984ull, 1024, 1073741824, 0, 3136},
{6, 8198468, 8004, 1024, 512, 192937984ull, 1536, 1073741824, 0, 3264},
{6, 8198980, 8004, 1024, 512, 209715200ull, 512, 1073741824, 0, 3392},
{6, 8199492, 8004, 1024, 512, 192937984ull, 2048, 1073741824, 0, 3520},
{6, 8200004, 8004, 1024, 512, 192937984ull, 2560, 1073741824, 0, 3648},
{6, 8200516, 8004, 1024, 512, 209715200ull, 1024, 1073741824, 0, 3776},
{6, 8201028, 8004, 1024, 3072, 192937984ull, 3072, 1073741824, 0, 3904},
{7, 1572864, 1024, 512, 1024, 216006656ull, 0, 1073741824, 0, 4672},
{7, 2097152, 1024, 512, 1024, 217055232ull, 0, 1073741824, 0, 4800},
{7, 2621440, 1024, 512, 1024, 218103808ull, 0, 1073741824, 0, 4928},
{8, 1048576, 1024, 1024, 1024, 221249536ull, 0, 1073741824, 0, 5056},
{12, 0, 2816, 1024, 2816, 223346688ull, 0, 32, 64, 5312},
{13, 0, 2816, 1024, 2816, 223346688ull, 32, 32, 64, 6016},
{14, 0, 1024, 2816, 1024, 234881024ull, 0, 1073741824, 0, 6720},
{17, 0, 3584, 1024, 3584, 3145728ull, 0, 32, 64, 7424},
{18, 0, 3584, 1024, 3584, 3145728ull, 32, 32, 64, 8320},
{19, 0, 1024, 3584, 1024, 120586240ull, 0, 1073741824, 0, 9216},
{17, 3670016, 3584, 1024, 3584, 17825792ull, 0, 32, 64, 10112},
{18, 3670016, 3584, 1024, 3584, 17825792ull, 32, 32, 64, 11008},
{19, 3670016, 1024, 3584, 1024, 127926272ull, 0, 1073741824, 0, 11904},
{17, 7340032, 3584, 1024, 3584, 32505856ull, 0, 32, 64, 12800},
{18, 7340032, 3584, 1024, 3584, 32505856ull, 32, 32, 64, 13696},
{19, 7340032, 1024, 3584, 1024, 135266304ull, 0, 1073741824, 0, 14592},
{17, 11010048, 3584, 1024, 3584, 47185920ull, 0, 32, 64, 15488},
{18, 11010048, 3584, 1024, 3584, 47185920ull, 32, 32, 64, 16384},
{19, 11010048, 1024, 3584, 1024, 142606336ull, 0, 1073741824, 0, 17280},
{17, 14680064, 3584, 1024, 3584, 61865984ull, 0, 32, 64, 18176},
{18, 14680064, 3584, 1024, 3584, 61865984ull, 32, 32, 64, 19072},
{19, 14680064, 1024, 3584, 1024, 149946368ull, 0, 1073741824, 0, 19968},
{17, 18350080, 3584, 1024, 3584, 76546048ull, 0, 32, 64, 20864},
{18, 18350080, 3584, 1024, 3584, 76546048ull, 32, 32, 64, 21760},
{19, 18350080, 1024, 3584, 1024, 157286400ull, 0, 1073741824, 0, 22656},
{17, 22020096, 3584, 1024, 3584, 91226112ull, 0, 32, 64, 23552},
{18, 22020096, 3584, 1024, 3584, 91226112ull, 32, 32, 64, 24448},
{19, 22020096, 1024, 3584, 1024, 164626432ull, 0, 1073741824, 0, 25344},
{17, 25690112, 3584, 1024, 3584, 105906176ull, 0, 32, 64, 26240},
{18, 25690112, 3584, 1024, 3584, 105906176ull, 32, 32, 64, 27136},
{19, 25690112, 1024, 3584, 1024, 171966464ull, 0, 1073741824, 0, 28032}
};

struct Args { const float* in[21]; float* out; unsigned char* ws; int ph_lo, ph_hi; };
__device__ __forceinline__ const float* karg_in(int i) {
    const __attribute__((address_space(4))) unsigned long long* p = (const __attribute__((address_space(4))) unsigned long long*)__builtin_amdgcn_kernarg_segment_ptr();
    int j = i; asm volatile("" : "+s"(j));
    return (const float*)p[j];
}
__device__ __forceinline__ int karg_int(int word) {
    const __attribute__((address_space(4))) int* p = (const __attribute__((address_space(4))) int*)__builtin_amdgcn_kernarg_segment_ptr();
    int j = word; asm volatile("" : "+s"(j));
    return p[j];
}
__device__ __forceinline__ unsigned char* wsp(unsigned char* ws, unsigned long long off) { asm volatile("" : "+s"(off)); return ws + off; }


struct TileSched {
    unsigned A, B, astep, bstep; int nM, nN, nwg, G, c, ord;
    __device__ void init(size_t A_, size_t B_, int M, int N, int lda, int ldb, int G_, int c_) {
        A = (unsigned)A_; B = (unsigned)B_; astep = 256u * lda * 2; bstep = 256u * ldb * 2; nM = M / 256; nN = N / 256; nwg = nM * nN; G = G_; c = c_; ord = 0; }
    __device__ bool next(int i, pg8::Unit& u) const {
        const int L = i * G + c; if (L >= nwg) return false;
#ifndef XCD_ORDER
        if (ord == 2 || (ord == 0 && nM == 64)) {
             u.pm = L / nN; u.pn = L - u.pm * nN; u.aux = 0; u.a = A + (unsigned)u.pm * astep; u.b = B + (unsigned)u.pn * bstep; return true; }
#endif
        int wgid = L; { const int q = nwg / pg8::NXCD, r = nwg % pg8::NXCD, xcd = wgid % pg8::NXCD, off = wgid / pg8::NXCD; wgid = (xcd < r ? xcd * (q + 1) : r * (q + 1) + (xcd - r) * q) + off; }
        const int nig = pg8::WGM * nN, gid = wgid / nig, fm = gid * pg8::WGM, gsz = (nM - fm) < pg8::WGM ? (nM - fm) : pg8::WGM;
        u.pm = fm + ((wgid % nig) % gsz); u.pn = (wgid % nig) / gsz; u.aux = 0; u.a = A + (unsigned)u.pm * astep; u.b = B + (unsigned)u.pn * bstep; return true;
    }
};
struct BranchSched {
    unsigned B; int c;
    __device__ bool next(int i, pg8::Unit& u) const {
        if (i >= 3 || c >= 256) return false;
        u.pm = c >> 2; u.pn = c & 3; u.aux = i;
        const unsigned Ab = (i == 0) ? (unsigned)WS_OA : (i == 1 ? (unsigned)WS_OB : (unsigned)WS_OC);
        u.a = Ab + (unsigned)u.pm * (256u * 512 * 2); u.b = B + (unsigned)i * (unsigned)MiB + (unsigned)u.pn * (256u * 512 * 2); return true;
    }
};
struct MoeSched {
    unsigned A, B; const int* tab; unsigned astep, bstep, estep; int nN, G, c; int ks; unsigned kbytes, kbytesA;
    __device__ bool next(int i, pg8::Unit& u) const {
        const int nt = tab[0];
#ifdef MOE_XCD
        if (ks == 1 && G == 256 && nN == 16) {
            const int x = c & 7, j = c >> 3;
            u.pm = i * 16 + (x >> 2) * 8 + (j >> 2); u.pn = (x & 3) * 4 + (j & 3); u.aux = 0;
            if (u.pm >= nt) return false;
            const int e = tab[1 + u.pm];
            u.a = A + (unsigned)u.pm * astep; u.b = B + (unsigned)e * estep + (unsigned)u.pn * bstep; return true;
        }
#endif
        const int L = i * G + c; if (L >= nt * nN * ks) return false;
        const int L2 = L / ks; u.aux = L - L2 * ks;
        u.pm = L2 / nN; u.pn = L2 - u.pm * nN;
        const int e = tab[1 + u.pm];
        u.a = A + (unsigned)u.pm * astep + (unsigned)u.aux * kbytesA; u.b = B + (unsigned)e * estep + (unsigned)u.pn * bstep + (unsigned)u.aux * kbytes; return true;
    }
};

template <class Sched>
__device__ __forceinline__ void fill_units(LAS unsigned char* lds, const Sched& S) {
    LAS u32x4* ut = (LAS u32x4*)(lds + pg8::UT_OFF);
    const int tid = otid();
    if (tid < 64) { pg8::Unit u; u.nt = 0; u32x4 e = {0u, 0u, 0u, 0u};
        if (S.next(tid, u)) { e.x = u.a; e.y = u.b; e.z = (unsigned)u.pm | ((unsigned)u.pn << 12) | ((unsigned)u.aux << 24); e.w = 0x10000u | (unsigned)u.nt; }
        ut[tid] = e; }
    __syncthreads();
}

#ifdef EPI_NT
#define EPI_ST16(p, v) __builtin_nontemporal_store((v), (p))
#else
#define EPI_ST16(p, v) (*(p) = (v))
constexpr int EPI_SCR_OFF = 133120, EPI_SCR_WAVE = 2304;
__device__ __forceinline__ void epi_store_16x64(LAS unsigned char* scr, bf16_t* tile  , size_t pitch, int fr, int fq, const u32x4& w0, const u32x4& w1) {
    *(LAS u32x4*)(scr + fr * 144 + fq * 16) = w0; *(LAS u32x4*)(scr + fr * 144 + 64 + fq * 16) = w1;
    const int lane = fr + 16 * fq, r8 = lane >> 3, ch = lane & 7;
    const u32x4 a = *(const LAS u32x4*)(scr + r8 * 144 + ch * 16), b = *(const LAS u32x4*)(scr + (r8 + 8) * 144 + ch * 16);
    *(GAS u32x4*)(tile + (size_t)r8 * pitch + ch * 8) = a; *(GAS u32x4*)(tile + (size_t)(r8 + 8) * pitch + ch * 8) = b;
}
#endif
__device__ __forceinline__ float sigmoidf_(float v) { return frcp(1.f + fexp2(-v * LOG2E)); }
struct EpiProj {
    static constexpr bool PERM = true;
    bf16_t* O; float* WI; LAS unsigned char* lds;
    __device__ __forceinline__ bool operator()(const f32x4 (&acc)[2][2][4][2], const pg8::Unit& u, int wr, int wc, int fr, int fq) const {
        const int pn = u.pn; const bool gate = (pn >= 12 && pn < 24);
        const float sc = (pn < 2 || pn == 4 || pn == 5 || pn == 8 || pn == 9) ? C2 : (pn == 24 ? 0.125f : 1.f);
        const int row0 = u.pm * 256 + wr * 64 + fr;
        LAS unsigned char* scr = lds + EPI_SCR_OFF + (wr * 4 + wc) * EPI_SCR_WAVE;
#pragma unroll
        for (int ai = 0; ai < 2; ++ai)
#pragma unroll
            for (int m = 0; m < 4; ++m) { u32x4 w[2];
#pragma unroll
                for (int bj = 0; bj < 2; ++bj) { f32x4 v0 = acc[ai][bj][m][0], v1 = acc[ai][bj][m][1];
                    if (gate) {
#pragma unroll
                        for (int k = 0; k < 4; ++k) { v0[k] = sigmoidf_(v0[k]); v1[k] = sigmoidf_(v1[k]); }
                    } else { v0 = v0 * sc; v1 = v1 * sc; }
                    w[bj].x = cvtpk(v0[0], v0[1]); w[bj].y = cvtpk(v0[2], v0[3]); w[bj].z = cvtpk(v1[0], v1[1]); w[bj].w = cvtpk(v1[2], v1[3]); }
                epi_store_16x64(scr, O + (size_t)(u.pm * 256 + wr * 64 + ai * 128 + m * 16) * NP + pn * 256 + wc * 64, NP, fr, fq, w[0], w[1]); }
        if (pn == 25 && wc == 1 && fq == 0) {
#pragma unroll
            for (int ai = 0; ai < 2; ++ai)
#pragma unroll
                for (int m = 0; m < 4; ++m) *(GAS f32x4*)(WI + (size_t)(row0 + ai * 128 + m * 16) * 4) = acc[ai][0][m][0] * 0.5f;
        }
        return false;
    }
};
struct EpiNone {
    static constexpr bool PERM = true;
    bf16_t* O;
    __device__ __forceinline__ bool operator()(const f32x4 (&acc)[2][2][4][2], const pg8::Unit& u, int wr, int wc, int fr, int fq) const {
        float s = 0.f;
#pragma unroll
        for (int ai = 0; ai < 2; ++ai)
#pragma unroll
            for (int bj = 0; bj < 2; ++bj)
#pragma unroll
                for (int m = 0; m < 4; ++m)
#pragma unroll
                    for (int n = 0; n < 2; ++n) s += acc[ai][bj][m][n][0] + acc[ai][bj][m][n][1] + acc[ai][bj][m][n][2] + acc[ai][bj][m][n][3];
        if (s == 1.2345e30f) O[0] = 1;
        return false;
    }
};
struct EpiQuarter {
    static constexpr bool PERM = true;
    bf16_t* O; int ldc;
    __device__ __forceinline__ bool operator()(const f32x4 (&acc)[2][2][4][2], const pg8::Unit& u, int wr, int wc, int fr, int fq) const {
        const int row0 = u.pm * 256 + wr * 64 + fr, col0 = u.pn * 256 + wc * 64 + 8 * fq;
        float s = 0.f;
#pragma unroll
        for (int ai = 0; ai < 2; ++ai)
#pragma unroll
            for (int m = 0; m < 4; ++m) { bf16_t* rowp = O + (size_t)(row0 + ai * 128 + m * 16) * ldc + col0;
#pragma unroll
                for (int bj = 0; bj < 2; ++bj) { const f32x4 v0 = acc[ai][bj][m][0], v1 = acc[ai][bj][m][1];
                    u32x4 w; w.x = cvtpk(v0[0], v0[1]); w.y = cvtpk(v0[2], v0[3]); w.z = cvtpk(v1[0], v1[1]); w.w = cvtpk(v1[2], v1[3]);
                    if (m == 0 && ai == 0) EPI_ST16((GAS u32x4*)(rowp + bj * 32), w); else s += __uint_as_float(w.x ^ w.y ^ w.z ^ w.w); } }
        if (s == 1.2345e30f) O[0] = 1;
        return false;
    }
};
struct EpiBlocked {
    static constexpr bool PERM = true;
    bf16_t* O;
    __device__ __forceinline__ bool operator()(const f32x4 (&acc)[2][2][4][2], const pg8::Unit& u, int wr, int wc, int fr, int fq) const {
        const int row0 = u.pm * 256 + wr * 64 + fr, col0 = wc * 64 + 8 * fq;
#pragma unroll
        for (int ai = 0; ai < 2; ++ai)
#pragma unroll
            for (int m = 0; m < 4; ++m) { bf16_t* rowp = O + (size_t)u.pn * ((size_t)T * 256) + (size_t)(row0 + ai * 128 + m * 16) * 256 + col0;
#pragma unroll
                for (int bj = 0; bj < 2; ++bj) { const f32x4 v0 = acc[ai][bj][m][0], v1 = acc[ai][bj][m][1];
                    u32x4 w; w.x = cvtpk(v0[0], v0[1]); w.y = cvtpk(v0[2], v0[3]); w.z = cvtpk(v1[0], v1[1]); w.w = cvtpk(v1[2], v1[3]);
                    *(GAS u32x4*)(rowp + bj * 32) = w; } }
        return false;
    }
};
struct EpiLinear {
    static constexpr bool PERM = true;
    bf16_t* O;
    __device__ __forceinline__ bool operator()(const f32x4 (&acc)[2][2][4][2], const pg8::Unit& u, int wr, int wc, int fr, int fq) const {
        const int lane = fr + 16 * fq, wv = wr * 4 + wc;
        bf16_t* base = O + ((size_t)(u.pm * 26 + u.pn) * 65536) + (size_t)wv * 8192 + lane * 8;
#pragma unroll
        for (int ai = 0; ai < 2; ++ai)
#pragma unroll
            for (int m = 0; m < 4; ++m)
#pragma unroll
                for (int bj = 0; bj < 2; ++bj) { const f32x4 v0 = acc[ai][bj][m][0], v1 = acc[ai][bj][m][1];
                    u32x4 w; w.x = cvtpk(v0[0], v0[1]); w.y = cvtpk(v0[2], v0[3]); w.z = cvtpk(v1[0], v1[1]); w.w = cvtpk(v1[2], v1[3]);
                    *(GAS u32x4*)(base + ((ai * 4 + m) * 2 + bj) * 512) = w; }
        return false;
    }
};
struct EpiBf16 {
    static constexpr bool PERM = true;
    bf16_t* O; int ldc; LAS unsigned char* lds;
    __device__ __forceinline__ bool operator()(const f32x4 (&acc)[2][2][4][2], const pg8::Unit& u, int wr, int wc, int fr, int fq) const {
        LAS unsigned char* scr = lds + EPI_SCR_OFF + (wr * 4 + wc) * EPI_SCR_WAVE;
#pragma unroll
        for (int ai = 0; ai < 2; ++ai)
#pragma unroll
            for (int m = 0; m < 4; ++m) { u32x4 w[2];
#pragma unroll
                for (int bj = 0; bj < 2; ++bj) { const f32x4 v0 = acc[ai][bj][m][0], v1 = acc[ai][bj][m][1];
                    w[bj].x = cvtpk(v0[0], v0[1]); w[bj].y = cvtpk(v0[2], v0[3]); w[bj].z = cvtpk(v1[0], v1[1]); w[bj].w = cvtpk(v1[2], v1[3]); }
                epi_store_16x64(scr, O + (size_t)(u.pm * 256 + wr * 64 + ai * 128 + m * 16) * ldc + u.pn * 256 + wc * 64, (size_t)ldc, fr, fq, w[0], w[1]); }
        return false;
    }
};
struct EpiBf16Split {
    static constexpr bool PERM = true;
    bf16_t* O0; bf16_t* O1; int ldc; LAS unsigned char* lds;
    __device__ __forceinline__ bool operator()(const f32x4 (&acc)[2][2][4][2], const pg8::Unit& u, int wr, int wc, int fr, int fq) const {
        bf16_t* O = u.aux ? O1 : O0;
        LAS unsigned char* scr = lds + EPI_SCR_OFF + (wr * 4 + wc) * EPI_SCR_WAVE;
#pragma unroll
        for (int ai = 0; ai < 2; ++ai)
#pragma unroll
            for (int m = 0; m < 4; ++m) { u32x4 w[2];
#pragma unroll
                for (int bj = 0; bj < 2; ++bj) { const f32x4 v0 = acc[ai][bj][m][0], v1 = acc[ai][bj][m][1];
                    w[bj].x = cvtpk(v0[0], v0[1]); w[bj].y = cvtpk(v0[2], v0[3]); w[bj].z = cvtpk(v1[0], v1[1]); w[bj].w = cvtpk(v1[2], v1[3]); }
                epi_store_16x64(scr, O + (size_t)(u.pm * 256 + wr * 64 + ai * 128 + m * 16) * ldc + u.pn * 256 + wc * 64, (size_t)ldc, fr, fq, w[0], w[1]); }
        return false;
    }
};
struct EpiBranch {
    static constexpr bool PERM = true;
    const bf16_t* G; bf16_t* O; LAS unsigned char* lds;
    static __device__ __forceinline__ float rat(float a, float b) { return a * frcp(fmaxf(b, 1e-30f)); }
    __device__ __forceinline__ bool operator()(f32x4 (&acc)[2][2][4][2], const pg8::Unit& u, int wr, int wc, int fr, int fq) const {
        const int sub = u.aux;
        const int row0 = u.pm * 256 + wr * 64 + fr, col0 = u.pn * 256 + wc * 64 + 8 * fq;
        LAS unsigned char* scr = lds + EPI_SCR_OFF + (wr * 4 + wc) * EPI_SCR_WAVE;
#pragma unroll
        for (int ai = 0; ai < 2; ++ai)
#pragma unroll
            for (int m = 0; m < 4; ++m) { const unsigned r = (unsigned)(row0 + ai * 128 + m * 16); u32x4 w[2];
#pragma unroll
                for (int bj = 0; bj < 2; ++bj) {
                    const bf16_t* gp = G + (size_t)r * NP + col0 + bj * 32;
                    const u32x4 gx = *(const GAS u32x4*)(gp + sub * 1024);
                    f32x4 f0 = {bf_lo(gx.x), bf_hi(gx.x), bf_lo(gx.y), bf_hi(gx.y)}, f1 = {bf_lo(gx.z), bf_hi(gx.z), bf_lo(gx.w), bf_hi(gx.w)};
                    if (sub < 2) { const u32x4 gy = *(const GAS u32x4*)(gp + (sub + 1) * 1024);
                        f0 = (f32x4){rat(f0.x, bf_lo(gy.x)), rat(f0.y, bf_hi(gy.x)), rat(f0.z, bf_lo(gy.y)), rat(f0.w, bf_hi(gy.y))};
                        f1 = (f32x4){rat(f1.x, bf_lo(gy.z)), rat(f1.y, bf_hi(gy.z)), rat(f1.z, bf_lo(gy.w)), rat(f1.w, bf_hi(gy.w))}; }
                    const f32x4 v0 = acc[ai][bj][m][0] * f0, v1 = acc[ai][bj][m][1] * f1;
                    acc[ai][bj][m][0] = v0; acc[ai][bj][m][1] = v1;
                    w[bj].x = cvtpk(v0[0], v0[1]); w[bj].y = cvtpk(v0[2], v0[3]); w[bj].z = cvtpk(v1[0], v1[1]); w[bj].w = cvtpk(v1[2], v1[3]); }
                if (sub == 2) epi_store_16x64(scr, O + (size_t)(u.pm * 256 + wr * 64 + ai * 128 + m * 16) * 1024 + u.pn * 256 + wc * 64, 1024, fr, fq, w[0], w[1]); }
        return sub < 2;
    }
};
struct EpiResid {
    static constexpr bool PERM = false;
    const float* xin; float* xout; const float* gate; LAS unsigned char* lds;
    __device__ __forceinline__ bool operator()(const f32x4 (&acc)[2][2][4][2], const pg8::Unit& u, int wr, int wc, int fr, int fq) const {
        const int row0 = u.pm * 256 + wr * 64 + fr, col0 = u.pn * 256 + wc * 64 + 4 * fq;
        const float* gp = gate + (size_t)(u.pm >> 4) * 6144 + col0;
        LAS unsigned char* scr = lds + EPI_SCR_OFF + (wr * 4 + wc) * EPI_SCR_WAVE;
        f32x4 gv[2][2];
#pragma unroll
        for (int bj = 0; bj < 2; ++bj)
#pragma unroll
            for (int n = 0; n < 2; ++n) gv[bj][n] = *(const GAS f32x4*)(gp + bj * 32 + n * 16);
#pragma unroll
        for (int am = 0; am < 8; am += 2) {
            f32x4 xv[2][2][2];
#pragma unroll
            for (int q = 0; q < 2; ++q) { const int ai = (am + q) >> 2, m = (am + q) & 3; const size_t off = (size_t)(row0 + ai * 128 + m * 16) * D + col0;
#pragma unroll
                for (int bj = 0; bj < 2; ++bj)
#pragma unroll
                    for (int n = 0; n < 2; ++n) xv[q][bj][n] = *(const GAS f32x4*)(xin + off + bj * 32 + n * 16); }
#pragma unroll
            for (int q = 0; q < 2; ++q) { const int ai = (am + q) >> 2, m = (am + q) & 3; const size_t off = (size_t)(row0 + ai * 128 + m * 16) * D + col0;
#pragma unroll
                for (int bj = 0; bj < 2; ++bj)
                    { const f32x4 r0 = xv[q][bj][0] + gv[bj][0] * acc[ai][bj][m][0], r1 = xv[q][bj][1] + gv[bj][1] * acc[ai][bj][m][1]; (void)off;
                      epi_store_16x64(scr, (bf16_t*)(xout + (size_t)(u.pm * 256 + wr * 64 + ai * 128 + m * 16) * D + u.pn * 256 + wc * 64 + bj * 32), 2 * (size_t)D, fr, fq, __builtin_bit_cast(u32x4, r0), __builtin_bit_cast(u32x4, r1)); } }
        }
        return false;
    }
};
struct EpiSwiGLU {
    static constexpr bool PERM = true;
    bf16_t* O; int ldc;
    __device__ __forceinline__ bool operator()(const f32x4 (&acc)[2][2][4][2], const pg8::Unit& u, int wr, int wc, int fr, int fq) const {
        bf16_t* ob = O + (size_t)u.pm * 256 * ldc + (size_t)(u.pn * 4 + wc) * 8192 + (wr * 64 + fr) * 32 + 8 * fq;
#pragma unroll
        for (int ai = 0; ai < 2; ++ai)
#pragma unroll
            for (int m = 0; m < 4; ++m) { float h[8];
#pragma unroll
                for (int n = 0; n < 2; ++n)
#pragma unroll
                    for (int k = 0; k < 4; ++k) { const float a = acc[ai][0][m][n][k], b = acc[ai][1][m][n][k]; h[n * 4 + k] = a * sigmoidf_(a) * b; }
                u32x4 w; w.x = cvtpk(h[0], h[1]); w.y = cvtpk(h[2], h[3]); w.z = cvtpk(h[4], h[5]); w.w = cvtpk(h[6], h[7]);
                EPI_ST16((GAS u32x4*)(ob + (ai * 128 + m * 16) * 32), w); }
        return false;
    }
};

struct Frame {
    LAS unsigned char* lds;
    int G, vcu, bx;
    unsigned char* ws;
};
#define THREAD_IDS() const int tid = otid(), lane = tid & 63, wave = __builtin_amdgcn_readfirstlane(tid >> 6); (void)lane; (void)wave
#define LDS_WAIT() asm volatile("s_waitcnt lgkmcnt(0)" ::: "memory")

__device__ __forceinline__ void transpose_item(const GAS float* W, const Seg& s, GAS unsigned char* ws, LAS float* scr, int item, int lane) {
    const int nblk = (s.ncols + 63) >> 6, kb = item / nblk, nb = item - kb * nblk, k0 = 64 * kb, n0 = 64 * nb;
    const int c4 = (lane & 15) * 4, rl = lane >> 4; const bool ok = (n0 + c4) < s.ncols;
    f32x4 v[16];
#pragma unroll
    for (int i = 0; i < 16; ++i) v[i] = ok ? *(const GAS f32x4*)(W + (size_t)(k0 + 4 * i + rl) * s.ldw + n0 + c4) : (f32x4){0.f, 0.f, 0.f, 0.f};
#pragma unroll
    for (int i = 0; i < 16; ++i) { LAS float* p = scr + (4 * i + rl) * 65 + c4; p[0] = v[i].x; p[1] = v[i].y; p[2] = v[i].z; p[3] = v[i].w; }
    LDS_WAIT(); asm volatile("" ::: "memory");
    const int c = lane & 7; GAS bf16_t* WT = (GAS bf16_t*)(ws + s.dst);
#pragma unroll
    for (int j = 0; j < 8; ++j) { const int n = (lane >> 3) + 8 * j, na = n0 + n; const LAS float* p = scr + (8 * c) * 65 + n;
        u32x4 o; o.x = cvtpk(p[0 * 65], p[1 * 65]); o.y = cvtpk(p[2 * 65], p[3 * 65]); o.z = cvtpk(p[4 * 65], p[5 * 65]); o.w = cvtpk(p[6 * 65], p[7 * 65]);
        if (na < s.ncols) { const int drow = s.row0 + (na / s.blk) * s.stride + (na % s.blk); *(GAS u32x4*)(WT + (size_t)drow * s.K + k0 + 8 * c) = o; } }
    LDS_WAIT(); asm volatile("" ::: "memory");
}
__device__ __forceinline__ void mod_unit(Frame& F, const float* c_, const float* w_ada_, const float* b_ada_, float* MOD_, int unit) {
    const GAS float* c = (const GAS float*)c_;
    const GAS float* w_ada = (const GAS float*)w_ada_;
    const GAS float* b_ada = (const GAS float*)b_ada_;
    GAS float* MOD = (GAS float*)MOD_;
    THREAD_IDS();
    LAS float* sc = (LAS float*)F.lds;
    LAS float* red = (LAS float*)(F.lds + 16384);
    for (int i = tid; i < 4096; i += NTHREADS) { const float v = c[i]; sc[i] = v * sigmoidf_(v); }
    __syncthreads();
    const int l = unit / 96, n = (unit % 96) * 64 + lane;
    const GAS float* wp = w_ada + (size_t)l * 1024 * 6144 + n;
    float a0 = 0.f, a1 = 0.f, a2 = 0.f, a3 = 0.f;
    const int kb = wave * 128;
#pragma unroll 8
    for (int k = 0; k < 128; ++k) { const float w = wp[(size_t)(kb + k) * 6144]; a0 += sc[kb + k] * w; a1 += sc[1024 + kb + k] * w; a2 += sc[2048 + kb + k] * w; a3 += sc[3072 + kb + k] * w; }
    red[(wave * 4 + 0) * 64 + lane] = a0; red[(wave * 4 + 1) * 64 + lane] = a1; red[(wave * 4 + 2) * 64 + lane] = a2; red[(wave * 4 + 3) * 64 + lane] = a3;
    __syncthreads();
    if (tid < 256) { const int b = tid >> 6, ln = tid & 63; float s = 0.f;
#pragma unroll
        for (int w = 0; w < 8; ++w) s += red[(w * 4 + b) * 64 + ln];
        const int nn = (unit % 96) * 64 + ln; MOD[((size_t)l * 4 + b) * 6144 + nn] = s + b_ada[l * 6144 + nn]; }
    __syncthreads();
}
__device__ __forceinline__ void p0_prologue(Frame& F) {
    THREAD_IDS();
    const int gw = F.bx * NWAVES + wave, NGW = F.G * NWAVES;
    if (F.bx < 192) mod_unit(F, karg_in(1), karg_in(2), karg_in(3), (float*)(F.ws + WS_MOD), F.bx);
    LAS unsigned long long* ptab = (LAS unsigned long long*)(F.lds + 140 * 1024);
    if (tid == 0) {
        ptab[6] = (unsigned long long)karg_in(6); ptab[7] = (unsigned long long)karg_in(7); ptab[8] = (unsigned long long)karg_in(8);
        ptab[12] = (unsigned long long)karg_in(12); ptab[13] = (unsigned long long)karg_in(13); ptab[14] = (unsigned long long)karg_in(14);
        ptab[17] = (unsigned long long)karg_in(17); ptab[18] = (unsigned long long)karg_in(18); ptab[19] = (unsigned long long)karg_in(19);
    }
    __syncthreads();
    LAS float* scr = (LAS float*)(F.lds + wave * 16640);
    int si = 0;
    for (int it = gw; it < SEG_ITEMS; it += NGW) {
        while (si + 1 < NSEG && g_segs[si + 1].item0 <= it) ++si;
        const Seg s = g_segs[si];
        const GAS float* W = (const GAS float*)ptab[s.in_idx] + s.src_off;
        transpose_item(W, s, (GAS unsigned char*)F.ws, scr, it - s.item0, lane);
    }
}

template <bool ROUTE>
__device__ __forceinline__ void norm_phase(Frame& F, const float* x_, const float* g_, const float* mod_sh_, const float* mod_sc_, bf16_t* XN_,
                                           const float* Wr_, const float* br_) {
    const GAS float* x = (const GAS float*)x_;
    const GAS float* g = (const GAS float*)g_;
    const GAS float* mod_sh = (const GAS float*)mod_sh_;
    const GAS float* mod_sc = (const GAS float*)mod_sc_;
    GAS bf16_t* XN = (GAS bf16_t*)XN_;
    const GAS float* Wr = (const GAS float*)Wr_;
    const GAS float* br = (const GAS float*)br_;
    THREAD_IDS();
    LAS float* wr_l = (LAS float*)F.lds;
    LAS int* e1s = (LAS int*)(F.lds + 32768); LAS int* e2s = e1s + 64;
    if (ROUTE) { for (int i = tid; i < 8192; i += NTHREADS) wr_l[i] = Wr[i]; __syncthreads(); }
    const int row0 = F.bx * 64 + wave * 8, b = row0 >> 12;
    f32x4 gain[4], sh[4];
#pragma unroll
    for (int j = 0; j < 4; ++j) { const int cidx = 4 * lane + 256 * j;
        const f32x4 gv = *(const GAS f32x4*)(g + cidx), sv = *(const GAS f32x4*)(mod_sc + (size_t)b * 6144 + cidx);
        gain[j] = gv * (sv + 1.0f); sh[j] = *(const GAS f32x4*)(mod_sh + (size_t)b * 6144 + cidx); }
    for (int r = 0; r < 8; ++r) {
        const int row = row0 + r;
        const GAS f32x4* xr = (const GAS f32x4*)(x + (size_t)row * D) + lane;
        f32x4 v[4]; float s = 0.f;
#pragma unroll
        for (int j = 0; j < 4; ++j) { v[j] = xr[64 * j]; s += (v[j].x * v[j].x + v[j].y * v[j].y) + (v[j].z * v[j].z + v[j].w * v[j].w); }
        const float rstd = 1.0f / sqrtf(wave_sum(s) * (1.f / D) + 1e-6f);
        GAS unsigned long long* o8 = (GAS unsigned long long*)(XN + (size_t)row * D) + lane;
#pragma unroll
        for (int j = 0; j < 4; ++j) { v[j] = (v[j] * rstd) * gain[j] + sh[j];
            o8[64 * j] = (unsigned long long)cvtpk(v[j].x, v[j].y) | ((unsigned long long)cvtpk(v[j].z, v[j].w) << 32); }
        if (ROUTE) {
            float lg[8];
#pragma unroll
            for (int e = 0; e < 8; ++e) lg[e] = 0.f;
#pragma unroll
            for (int j = 0; j < 4; ++j)
#pragma unroll
                for (int k = 0; k < 4; ++k) { const LAS f32x4* wp = (const LAS f32x4*)(wr_l + (size_t)(4 * lane + 256 * j + k) * 8); const f32x4 w0 = wp[0], w1 = wp[1]; const float hv = v[j][k];
                    lg[0] += hv * w0.x; lg[1] += hv * w0.y; lg[2] += hv * w0.z; lg[3] += hv * w0.w; lg[4] += hv * w1.x; lg[5] += hv * w1.y; lg[6] += hv * w1.z; lg[7] += hv * w1.w; }
#pragma unroll
            for (int e = 0; e < 8; ++e) lg[e] = wave_sum(lg[e]) + br[e];
            int i1 = 0; float v1 = lg[0];
#pragma unroll
            for (int e = 1; e < 8; ++e) if (lg[e] > v1) { v1 = lg[e]; i1 = e; }
            int i2 = -1; float v2 = -INFINITY;
#pragma unroll
            for (int e = 0; e < 8; ++e) if (e != i1 && lg[e] > v2) { v2 = lg[e]; i2 = e; }
            const float w2 = frcp(1.f + __expf(v1 - v2)), w1 = 1.f - w2;
            if (lane == 0) { e1s[wave * 8 + r] = i1; e2s[wave * 8 + r] = i2; *(f32x2*)(F.ws + WS_RTW + (size_t)row * 8) = (f32x2){w1, w2}; }
        }
    }
    if (ROUTE) {
        __syncthreads();
        if (wave == 0) {
            const int e1 = e1s[lane], e2 = e2s[lane]; int r1 = 0, r2 = 0;
            const unsigned long long lt = (lane == 0) ? 0ull : (~0ull >> (64 - lane));
#pragma unroll
            for (int e = 0; e < 8; ++e) { const unsigned long long b1 = __ballot(e1 == e), b2 = __ballot(e2 == e); const int c1 = __builtin_popcountll(b1);
                if (e1 == e) r1 = __builtin_popcountll(b1 & lt);
                if (e2 == e) r2 = c1 + __builtin_popcountll(b2 & lt);
                if (lane == e) ((unsigned*)(F.ws + WS_WGCNT))[F.bx * 8 + e] = (unsigned)(c1 + __builtin_popcountll(b2)); }
            ((unsigned*)(F.ws + WS_RTE))[F.bx * 64 + lane] = (unsigned)e1 | ((unsigned)e2 << 8) | ((unsigned)r1 << 16) | ((unsigned)r2 << 24);
        }
        __syncthreads();
    }
}
__device__ __forceinline__ void moe_gather_phase(Frame& F, const bf16_t* XN_, bf16_t* XP_) {
    const GAS bf16_t* XN = (const GAS bf16_t*)XN_;
    GAS bf16_t* XP = (GAS bf16_t*)XP_;
    THREAD_IDS();
    LAS unsigned* cnt = (LAS unsigned*)F.lds;
    LAS int* segs = (LAS int*)(F.lds + 8192);
    const unsigned* wg = (const unsigned*)(F.ws + WS_WGCNT);
    for (int i = tid; i < 2048; i += NTHREADS) cnt[i] = wg[i];
    __syncthreads();
    if (tid < 8) { int tot = 0, base = 0; for (int w = 0; w < 256; ++w) { const int c = (int)cnt[w * 8 + tid]; if (w < F.bx) base += c; tot += c; } segs[32 + tid] = tot; segs[8 + tid] = base; }
    __syncthreads();
    if (tid == 0) { int st = 0; for (int e = 0; e < 8; ++e) { segs[e] = st; st += (segs[32 + e] + 255) & ~255; } segs[16] = st;
        if (F.bx == 0) { int* tab = (int*)(F.ws + WS_TILETAB); tab[0] = st >> 8; for (int e = 0; e < 8; ++e) { const int t0 = segs[e] >> 8, t1 = (e < 7 ? segs[e + 1] : st) >> 8; for (int t = t0; t < t1; ++t) tab[1 + t] = e; } } }
    __syncthreads();
    for (int r = 0; r < 8; ++r) {
        const int row = F.bx * 64 + wave * 8 + r;
        const unsigned rt = ((const unsigned*)(F.ws + WS_RTE))[row];
        const int e1 = rt & 255, e2 = (rt >> 8) & 255, r1 = (rt >> 16) & 255, r2 = rt >> 24;
        const int p1 = segs[e1] + segs[8 + e1] + r1, p2 = segs[e2] + segs[8 + e2] + r2;
        const GAS u32x4* src = (const GAS u32x4*)(XN + (size_t)row * D) + lane; const u32x4 a = src[0], bq = src[64];
        GAS u32x4* d1 = (GAS u32x4*)(XP + (size_t)p1 * D) + lane; d1[0] = a; d1[64] = bq;
        GAS u32x4* d2 = (GAS u32x4*)(XP + (size_t)p2 * D) + lane; d2[0] = a; d2[64] = bq;
        if (lane == 0) { int* pos = (int*)(F.ws + WS_POS) + (size_t)row * 2; pos[0] = p1; pos[1] = p2; }
    }
}
__device__ __forceinline__ void final_phase(Frame& F, float* x_, const bf16_t* Y_, const bf16_t* Z_, const float* g2_, const float* fg_) {
    GAS float* x = (GAS float*)x_;
    const GAS bf16_t* Y = (const GAS bf16_t*)Y_;
    const GAS bf16_t* Z = (const GAS bf16_t*)Z_;
    const GAS float* g2 = (const GAS float*)g2_;
    const GAS float* fg = (const GAS float*)fg_;
    THREAD_IDS();
    const int row0 = F.bx * 64 + wave * 8, b = row0 >> 12;
    f32x4 gate[4], fgv[4];
#pragma unroll
    for (int j = 0; j < 4; ++j) { const int cidx = 4 * lane + 256 * j; gate[j] = *(const GAS f32x4*)(g2 + (size_t)b * 6144 + cidx); fgv[j] = *(const GAS f32x4*)(fg + cidx); }
    for (int r = 0; r < 8; ++r) {
        const int row = row0 + r;
        const int* pos = (const int*)(F.ws + WS_POS) + (size_t)row * 2; const int p1 = pos[0], p2 = pos[1];
        const f32x2 wv = *(const f32x2*)(F.ws + WS_RTW + (size_t)row * 8);
        GAS f32x4* xr = (GAS f32x4*)(x + (size_t)row * D) + lane;
        const GAS u32x2* y1 = (const GAS u32x2*)(Y + (size_t)p1 * D) + lane; const GAS u32x2* y2 = (const GAS u32x2*)(Y + (size_t)p2 * D) + lane;
        const GAS u32x2* z1 = (const GAS u32x2*)(Z + (size_t)p1 * D) + lane; const GAS u32x2* z2 = (const GAS u32x2*)(Z + (size_t)p2 * D) + lane;
        f32x4 v[4]; float s = 0.f;
#pragma unroll
        for (int j = 0; j < 4; ++j) { const u32x2 a = y1[64 * j], c = y2[64 * j]; u32x2 a2 = {0u, 0u}, c2 = {0u, 0u};
            a2 = z1[64 * j]; c2 = z2[64 * j];
            const f32x4 ya = (f32x4){bf_lo(a.x), bf_hi(a.x), bf_lo(a.y), bf_hi(a.y)} + (f32x4){bf_lo(a2.x), bf_hi(a2.x), bf_lo(a2.y), bf_hi(a2.y)};
            const f32x4 yc = (f32x4){bf_lo(c.x), bf_hi(c.x), bf_lo(c.y), bf_hi(c.y)} + (f32x4){bf_lo(c2.x), bf_hi(c2.x), bf_lo(c2.y), bf_hi(c2.y)};
            v[j] = xr[64 * j] + gate[j] * (ya * wv.x + yc * wv.y);
            s += (v[j].x * v[j].x + v[j].y * v[j].y) + (v[j].z * v[j].z + v[j].w * v[j].w); }
        const float rstd = 1.0f / sqrtf(wave_sum(s) * (1.f / D) + 1e-6f);
#pragma unroll
        for (int j = 0; j < 4; ++j) xr[64 * j] = (v[j] * rstd) * fgv[j];
    }
}

__device__ __forceinline__ int pi_perm(int r) { return (r & 0x13) | ((r & 4) << 1) | ((r & 8) >> 1); }
__device__ __forceinline__ u32x4 tile_gload(const GAS bf16_t* g, size_t pitch, int tid) {
    const int row = tid >> 3, pc = tid & 7, c = pc ^ ((row >> 1) & 7);
    return *(const GAS u32x4*)(g + (size_t)row * pitch + c * 8);
}
__device__ __forceinline__ bf16x8 lfrag(const LAS unsigned char* p) { return *(const LAS bf16x8*)p; }
__device__ __forceinline__ bf16x8 pack8(const f32x16& p, int s) {
    u32x4 w; w.x = cvtpk(p[8 * s + 0], p[8 * s + 1]); w.y = cvtpk(p[8 * s + 2], p[8 * s + 3]); w.z = cvtpk(p[8 * s + 4], p[8 * s + 5]); w.w = cvtpk(p[8 * s + 6], p[8 * s + 7]);
    return __builtin_bit_cast(bf16x8, w);
}
__device__ __forceinline__ int t5_bucket(int rel) {
    const int n = rel < 0 ? -rel : rel;
    const int large = 8 + (n >= 12) + (n >= 16) + (n >= 23) + (n >= 32) + (n >= 46) + (n >= 64) + (n >= 91);
    return (rel > 0 ? 16 : 0) + (n < 8 ? n : large);
}
__device__ __forceinline__ float max3f(float a, float b, float c) { float r; asm("v_max3_f32 %0, %1, %2, %3" : "=v"(r) : "v"(a), "v"(b), "v"(c)); return r; }
__device__ __forceinline__ float max16(const f32x16& a) {
    float m0 = max3f(a[0], a[1], a[2]), m1 = max3f(a[3], a[4], a[5]); m0 = max3f(m0, a[6], a[7]); m1 = max3f(m1, a[8], a[9]);
    m0 = max3f(m0, a[10], a[11]); m1 = max3f(m1, a[12], a[13]); m0 = max3f(m0, a[14], a[15]);
    return max3f(m0, m1, m1);
}
__device__ __forceinline__ unsigned bitmask1(unsigned w, int bit) { int t = __builtin_amdgcn_sbfe((int)w, bit, 1); asm("" : "+v"(t)); return (unsigned)t; }
#define MFMA32(a, b, c) __builtin_amdgcn_mfma_f32_32x32x16_bf16((a), (b), (c), 0, 0, 0)

__device__ __forceinline__ void topk_unit(Frame& F, int b, int ci, int j, const bf16_t* PROJ_, const float* WI_, unsigned long long* MASK_) {
    const GAS bf16_t* PROJ = (const GAS bf16_t*)PROJ_;
    const GAS float* WI = (const GAS float*)WI_;
    GAS unsigned long long* MASK = (GAS unsigned long long*)MASK_;
    const int t0 = b * SEQ + 64 * ci + 8 * j, nreg = ci + 1;
    THREAD_IDS(); const int r32 = lane & 31, half = lane >> 5;
    if (ci < 4) {
        MASK[(size_t)(t0 + wave) * 64 + lane] = (lane < nreg) ? ~0ull : 0ull;
        return;
    }
    LAS unsigned* scu = (LAS unsigned*)F.lds;
#ifndef TOPK_DUP
#define TOPK_DUP 0
#endif
    for (int rep1 = 0; rep1 < (TOPK_DUP == 1 ? 2 : 1); ++rep1) {
        const int n16 = lane & 15, kq = lane >> 4;
        bf16x8 af[2][2]; f32x4 wv[2];
#pragma unroll
        for (int mt = 0; mt < 2; ++mt) {
#pragma unroll
            for (int jk = 0; jk < 2; ++jk) af[mt][jk] = *(const GAS bf16x8*)(PROJ + (size_t)(t0 + 4 * mt + (n16 >> 2)) * NP + C_QI + (n16 & 3) * 64 + 32 * jk + 8 * kq);
            wv[mt] = *(const GAS f32x4*)(WI + (size_t)(t0 + 4 * mt + kq) * 4);
        }
#ifndef TKB
#define TKB 16
#endif
        for (int kb0 = wave * TKB; kb0 < 4 * nreg; kb0 += 8 * TKB) {
            bf16x8 bfr[TKB][2];
#pragma unroll
            for (int u = 0; u < TKB; ++u) { const int kb = (kb0 + u < 4 * nreg) ? kb0 + u : kb0;
                                const GAS bf16_t* kp = PROJ + (size_t)(b * SEQ + 16 * kb + n16) * NP + C_KI + 8 * kq;
                bfr[u][0] = *(const GAS bf16x8*)kp; bfr[u][1] = *(const GAS bf16x8*)(kp + 32); }
#pragma unroll
            for (int u = 0; u < TKB; ++u) if (kb0 + u < 4 * nreg) {
#pragma unroll
                for (int mt = 0; mt < 2; ++mt) {
                    f32x4 acc = {0.f, 0.f, 0.f, 0.f};
                    acc = __builtin_amdgcn_mfma_f32_16x16x32_bf16(af[mt][0], bfr[u][0], acc, 0, 0, 0);
                    acc = __builtin_amdgcn_mfma_f32_16x16x32_bf16(af[mt][1], bfr[u][1], acc, 0, 0, 0);
                    const float s = wv[mt].x * fmaxf(acc.x, 0.f) + wv[mt].y * fmaxf(acc.y, 0.f) + wv[mt].z * fmaxf(acc.z, 0.f) + wv[mt].w * fmaxf(acc.w, 0.f);
                    const unsigned sb = __float_as_uint(s + 0.0f);
                    scu[(4 * mt + kq) * 4096 + ((16 * (kb0 + u) + n16) ^ (16 * (kq & 1)))] = sb ^ (((unsigned)((int)sb >> 31)) | 0x80000000u);
                }
            }
        }
    }
    __syncthreads();
    for (int rep2 = (TOPK_DUP == 2 ? 0 : 1); rep2 < 2; ++rep2) {
        unsigned key[64];
#pragma unroll
        for (int r = 0; r < 64; ++r) {
            const unsigned k = scu[wave * 4096 + ((64 * r + lane) ^ (16 * (wave & 1)))];
            key[r] = (r < nreg) ? k : 0u;
        }
#ifndef TKG
#define TKG 8
#endif
        unsigned Tt = 0u; int cge = 0;
#ifdef TOPK_ABL
        if (rep2 == 0) { Tt = 0x80000000u; cge = (TOPK_ABL == 1) ? 256 : 257; }
#endif
        for (int bit = 32; bit >= 0; ) {
#ifdef TOPK_ABL
            if (rep2 == 0) break;
#endif
            const unsigned cand = (bit == 32) ? 0x80000001u : (bit == 31) ? 0x80000000u : (Tt | (1u << bit)); int vc = 0;
#pragma unroll
            for (int g4 = 0; g4 < 64 / TKG; ++g4) if (g4 * TKG < nreg) {
#pragma unroll
                for (int r = 0; r < TKG; r += 4)
                    asm volatile("v_cmp_ge_u32_e64 s[80:81], %1, %5\n\tv_cmp_ge_u32_e64 s[82:83], %2, %5\n\tv_cmp_ge_u32_e64 s[84:85], %3, %5\n\tv_cmp_ge_u32_e64 s[86:87], %4, %5\n\t"
                                 "v_addc_co_u32_e64 %0, s[80:81], %0, 0, s[80:81]\n\tv_addc_co_u32_e64 %0, s[82:83], %0, 0, s[82:83]\n\t"
                                 "v_addc_co_u32_e64 %0, s[84:85], %0, 0, s[84:85]\n\tv_addc_co_u32_e64 %0, s[86:87], %0, 0, s[86:87]"
                                 : "+v"(vc) : "v"(key[g4 * TKG + r]), "v"(key[g4 * TKG + r + 1]), "v"(key[g4 * TKG + r + 2]), "v"(key[g4 * TKG + r + 3]), "s"(cand)
                                 : "s80", "s81", "s82", "s83", "s84", "s85", "s86", "s87");
            }
            const int cnt = wave_sum_i32(vc);
            if (bit == 32) { if (cnt == 256) { Tt = cand; cge = 256; break; } if (cnt > 256) { Tt = 0x80000000u; bit = 30; } else bit = 31; continue; }
            if (bit == 31) { if (cnt >= 256) { Tt = cand; cge = cnt; break; } bit = 30; continue; }
            if (cnt >= 256) { Tt = cand; cge = cnt; if (cnt == 256) break; }
            --bit;
        }
        LAS unsigned long long* wl = (LAS unsigned long long*)(F.lds + 131072 + wave * 512);
        if (cge == 256) {
            unsigned mlo = 0u, mhi = 0u;
#pragma unroll
            for (int r = 0; r < 64; ++r) { const unsigned long long ge = __ballot(key[r] >= Tt);
                asm volatile("s_mov_b32 s80, %2\n\ts_mov_b32 s81, %3\n\ts_nop 4\n\tv_writelane_b32 %0, s80, %4\n\tv_writelane_b32 %1, s81, %4"
                             : "+v"(mlo), "+v"(mhi) : "s"((unsigned)ge), "s"((unsigned)(ge >> 32)), "n"(r) : "s80", "s81"); }
            MASK[(size_t)(t0 + wave) * 64 + lane] = ((unsigned long long)mhi << 32) | mlo;
        } else {
            int cgt = 0;
            for (int r = 0; r < nreg; ++r) { const unsigned k = scu[wave * 4096 + ((64 * r + lane) ^ (16 * (wave & 1)))]; cgt += __builtin_popcountll(__ballot(k > Tt)); }
            int need = 256 - cgt;
            for (int r = 0; r < nreg; ++r) { const unsigned k = scu[wave * 4096 + ((64 * r + lane) ^ (16 * (wave & 1)))];
                const unsigned long long gt = __ballot(k > Tt), eq = __ballot(k == Tt);
                unsigned long long sel = eq; int c = __builtin_popcountll(eq);
                if (c > need) { sel = 0ull; unsigned long long m = eq; for (int q = 0; q < need; ++q) { const unsigned long long low = m & (0ull - m); sel |= low; m ^= low; } c = need; }
                need -= c;
                if (lane == 0) wl[r] = gt | sel; }
            for (int r = nreg + lane; r < 64; r += 64) wl[r] = 0ull;
            MASK[(size_t)(t0 + wave) * 64 + lane] = wl[lane];
        }
    }
    __syncthreads();
}

template <int MODE, int ORD, int ATP = 0>
__device__ __forceinline__ void attn_unit(Frame& F, int b, int h, int qb, const bf16_t* PROJ_, const bf16_t* VT_, const unsigned long long* MASK_, bf16_t* OUT_,
                                          const float* rel_bias_, const float* lamp_, const float* subg_, float lam_init) {
    const GAS bf16_t* PROJ = (const GAS bf16_t*)PROJ_; const GAS bf16_t* VT = (const GAS bf16_t*)VT_; const GAS unsigned long long* MASK = (const GAS unsigned long long*)MASK_;
    GAS bf16_t* OUT = (GAS bf16_t*)OUT_; const GAS float* rel_bias = (const GAS float*)rel_bias_; const GAS float* lamp = (const GAS float*)lamp_; const GAS float* subg = (const GAS float*)subg_;
    constexpr int NDB = MODE ? 4 : 2, KS = MODE ? 16384 : 8192, VS = MODE ? 16384 : 8192, KSL = MODE ? 2 : 3, VSL = MODE ? 4 : 5, FD = MODE ? 2 : 3, VR = KSL * KS, BT = VR + VSL * VS;
    THREAD_IDS(); const int r32 = lane & 31, half = lane >> 5, map = MODE ? (wave >> 2) : 0, wq = MODE ? (wave & 3) : wave;
    LAS unsigned char* buf = F.lds; LAS float* btab = (LAS float*)(F.lds + BT);
    const int tokb = b * SEQ, qw = (MODE ? qb * 128 : qb * 256) + 32 * wq, ntw = (qw >> 6) + 1, nt = MODE ? 2 * qb + 2 : 4 * qb + 4;
    const float bfar = rel_bias[15 * 12 + (MODE ? 8 : 0) + h] * LOG2E;
    if (tid < 192) btab[tid] = rel_bias[t5_bucket(tid - 128) * 12 + (MODE ? 8 : 0) + h] * LOG2E - bfar;
    bf16x8 qf[4];
    LAS bf16x8* qpark = (LAS bf16x8*)(F.lds + BT + 1024 + wave * 4096) + lane;
#pragma unroll
    for (int ds = 0; ds < 4; ++ds) { qf[ds] = *(const GAS bf16x8*)(PROJ + (size_t)(tokb + qw + r32) * NP + (MODE ? C_QB + h * 128 + map * 64 : C_QA + h * 64) + 16 * ds + 8 * half);
        qpark[ds * 64] = qf[ds]; }
    const int prow = pi_perm(r32), swk = (prow >> 1) & 7, swv = (r32 >> 1) & 7;
    const int koff0 = map * 8192 + prow * 128 + ((half ^ swk) << 4), voff0 = VR + r32 * 128 + ((half ^ swv) << 4);
#define koff(k) (koff0 ^ ((k) << 5))
#define voff(k) (voff0 ^ ((k) << 5))
    const GAS bf16_t* kg = PROJ + (size_t)tokb * NP + (MODE ? C_KB + h * 128 : C_KA + h * 64);
    const GAS bf16_t* vg = VT + (size_t)(MODE ? 512 + h * 128 : h * 64) * VTP + tokb;
    const GAS unsigned long long* mrow = MASK + (size_t)(tokb + qw + r32) * 64;
    float m_run = 0.f, l_run = 0.f, cref = 0.f, sref = 0.f, nref = 0.f; f32x16 O[NDB], cv;
#pragma unroll
    for (int d = 0; d < NDB; ++d)
#pragma unroll
        for (int i = 0; i < 16; ++i) O[d][i] = 0.f;
    const int drow = tid >> 3, dch = ((tid & 7) ^ ((drow >> 1) & 7)) * 8;
    const GAS bf16_t* kgl = kg + (size_t)drow * NP + dch; const GAS bf16_t* vgl = vg + (size_t)drow * VTP + dch;
#ifdef AT_SETPRIO
#define AT_PRIO(p) __builtin_amdgcn_s_setprio(p)
#else
#define AT_PRIO(p) do { } while (0)
#endif
#define AT_DMA(gp, off) __builtin_amdgcn_global_load_lds((const GAS unsigned*)(gp), (LAS unsigned*)(buf + (off) + wave * 1024), 16, 0, 0)
#define AT_KLOAD(tt) do { const int t_ = (tt); const GAS bf16_t* kn_ = kgl + (size_t)t_ * 64 * NP; const int ko_ = (t_ % KSL) * KS; AT_DMA(kn_, ko_); if (MODE) AT_DMA(kn_ + 64, ko_ + 8192); } while (0)
#define AT_VLOAD(tt) do { const int t_ = (tt); const GAS bf16_t* vn_ = vgl + t_ * 64; const int vo_ = VR + (t_ % VSL) * VS; AT_DMA(vn_, vo_); if (MODE) AT_DMA(vn_ + (size_t)64 * VTP, vo_ + 8192); } while (0)
#define AT_QK(S0, S1, tt, RF) do { const int t_ = (tt); const LAS unsigned char* kb_ = buf + (t_ % KSL) * KS; const bool far_ = ATP ? true : (64 * t_ <= qw - 154); RF = cref; \
        AT_PRIO(1); { const bf16x8 q_ = qpark[0]; if (MODE) { const float c_ = bfar - cref; _Pragma("unroll") for (int i = 0; i < 16; ++i) { S0[i] = c_; S1[i] = c_; } S0 = MFMA32(lfrag(kb_ + koff(0)), q_, S0); S1 = MFMA32(lfrag(kb_ + 4096 + koff(0)), q_, S1); } \
          else { S0 = MFMA32(lfrag(kb_ + koff(0)), q_, cv); S1 = MFMA32(lfrag(kb_ + 4096 + koff(0)), q_, cv); } } \
        _Pragma("unroll") for (int ds = 1; ds < 4; ++ds) { const bf16x8 q_ = qpark[ds * 64]; S0 = MFMA32(lfrag(kb_ + koff(ds)), q_, S0); S1 = MFMA32(lfrag(kb_ + 4096 + koff(ds)), q_, S1); } AT_PRIO(0); \
        if (!far_) { const int base_ = 64 * t_ + 8 * half - (qw + r32) + 128; \
            _Pragma("unroll") for (int i = 0; i < 16; ++i) { const int o_ = 16 * (i >> 3) + (i & 7); int i0 = base_ + o_, i1 = base_ + 32 + o_; i0 = i0 < 0 ? 0 : i0; i1 = i1 < 0 ? 0 : i1; S0[i] += btab[i0]; S1[i] += btab[i1]; } } } while (0)
#define AT_SETREF() do { cref = m_run; if (!MODE) { _Pragma("unroll") for (int i = 0; i < 16; ++i) cv[i] = bfar - m_run; } } while (0)
#define AT_PV(tt) do { const LAS unsigned char* vb_ = buf + ((tt) % VSL) * VS; AT_PRIO(1); \
        _Pragma("unroll") for (int db = 0; db < NDB; ++db) { \
            O[db] = MFMA32(lfrag(vb_ + db * 4096 + voff(0)), pf0, O[db]); O[db] = MFMA32(lfrag(vb_ + db * 4096 + voff(1)), pf1, O[db]); \
            O[db] = MFMA32(lfrag(vb_ + db * 4096 + voff(2)), pf2, O[db]); O[db] = MFMA32(lfrag(vb_ + db * 4096 + voff(3)), pf3, O[db]); } AT_PRIO(0); } while (0)
    AT_KLOAD(0); AT_VLOAD(0); AT_KLOAD(1); AT_VLOAD(1); if (FD == 3) { AT_KLOAD(2 < nt ? 2 : nt - 1); AT_VLOAD(2 < nt ? 2 : nt - 1); }
    unsigned long long mcur = 0ull, mnext = 0ull;
    if (!MODE) { mcur = mrow[0]; mnext = mrow[ntw > 1 ? 1 : 0]; }
    __syncthreads();
    f32x16 s0, s1, n0, n1; bf16x8 pf0, pf1, pf2, pf3;
    {   bf16x8 z;
#pragma unroll
        for (int i = 0; i < 8; ++i) z[i] = 0;
        pf0 = z; pf1 = z; pf2 = z; pf3 = z; }
#pragma unroll
    for (int i = 0; i < 16; ++i) { n0[i] = 0.f; n1[i] = 0.f; }
    AT_SETREF();
    AT_QK(s0, s1, 0, sref);
    float mtc = fmaxf(max16(s0), max16(s1)); mtc = fmaxf(mtc, xhalf(mtc)) + sref; float mtn = mtc;
#define AT_SOFTMAX(s0, s1, sref) do { if (ATP || t < ntw) { \
            float mt = fmaxf(max16(s0), max16(s1)); mt = fmaxf(mt, xhalf(mt)) + sref;                   \
            if (!ATP && (t == 0 || __any(mt > m_run + 8.0f))) {                                                   \
                const float mn = (t == 0) ? mt : fmaxf(m_run, mt); alpha = (t == 0) ? 1.f : fexp2(m_run - mn); l_run *= alpha; m_run = mn; resc = (t != 0); AT_SETREF(); } \
            const float dl = sref - m_run; \
            if (!ATP && __any(dl != 0.f)) { _Pragma("unroll") for (int i = 0; i < 16; ++i) { s0[i] += dl; s1[i] += dl; } }        \
            float ls = 0.f; \
            if (!MODE) { \
                const unsigned long long mw = mcur >> (8 * half); const unsigned mlo = (unsigned)mw, mhi = (unsigned)(mw >> 32); \
                _Pragma("unroll") for (int i = 0; i < 16; ++i) { const int bitp = 16 * (i >> 3) + (i & 7); \
                    const float p0 = __uint_as_float(__float_as_uint(fexp2(s0[i])) & bitmask1(mlo, bitp)); \
                    const float p1 = __uint_as_float(__float_as_uint(fexp2(s1[i])) & bitmask1(mhi, bitp)); \
                    s0[i] = p0; s1[i] = p1; ls += p0 + p1; } \
            } else { \
                _Pragma("unroll") for (int i = 0; i < 16; ++i) { s0[i] = fexp2(s0[i]); s1[i] = fexp2(s1[i]); ls += s0[i] + s1[i]; } \
            } \
            l_run += ls; } \
        if (resc) { _Pragma("unroll") for (int d = 0; d < NDB; ++d) _Pragma("unroll") for (int i = 0; i < 16; ++i) O[d][i] *= alpha; } \
        if (ATP || t < ntw) { pf0 = pack8(s0, 0); pf1 = pack8(s0, 1); pf2 = pack8(s1, 0); pf3 = pack8(s1, 1); } } while (0)
#define AT_HEAD() \
        unsigned long long mfut = 0ull; \
        if (!MODE && (ATP ? true : (t + 2 < ntw))) mfut = mrow[ATP ? ((t + 2) & 63) : t + 2]; \
        asm volatile("" ::: "memory"); \
        AT_KLOAD(t + FD < nt ? t + FD : nt - 1); AT_VLOAD(t + FD < nt ? t + FD : nt - 1);        \
        float alpha = 1.f; bool resc = false;
#define AT_TAIL() \
        s0 = n0; s1 = n1; sref = nref; mcur = mnext; mnext = mfut; mtc = mtn; \
          \
        if (MODE) asm volatile("s_waitcnt vmcnt(0) lgkmcnt(0)" ::: "memory"); else asm volatile("s_waitcnt vmcnt(3) lgkmcnt(0)" ::: "memory"); \
        __builtin_amdgcn_s_barrier(); asm volatile("" ::: "memory");
#define AT_STEP_G() do { AT_HEAD() \
        if (ORD == 0) { \
            if (ATP || t + 1 < ntw) { AT_QK(n0, n1, (ATP ? (t + 1 < nt ? t + 1 : t) : t + 1), nref); mtn = fmaxf(max16(n0), max16(n1)); mtn = fmaxf(mtn, xhalf(mtn)) + nref; } \
            if (ATP || (t >= 1 && t <= ntw)) AT_PV(ATP ? (t >= 1 ? t - 1 : 0) : t - 1); \
            AT_SOFTMAX(s0, s1, sref);                                \
        } else { \
            if (ATP || (t >= 1 && t <= ntw)) AT_PV(ATP ? (t >= 1 ? t - 1 : 0) : t - 1); \
            AT_SOFTMAX(s0, s1, sref); \
            if (ATP || t + 1 < ntw) { AT_QK(n0, n1, (ATP ? (t + 1 < nt ? t + 1 : t) : t + 1), nref); mtn = fmaxf(max16(n0), max16(n1)); mtn = fmaxf(mtn, xhalf(mtn)) + nref; } \
        } \
        AT_TAIL() } while (0)
#define AT_STEP_F() do { AT_HEAD() \
              \
              \
            if (__any(mtc > m_run + 8.0f)) { const float mn = fmaxf(m_run, mtc); alpha = fexp2(m_run - mn); l_run *= alpha; m_run = mn; resc = true; AT_SETREF(); } \
            { const float dl = sref - m_run; if (__any(dl != 0.f)) { _Pragma("unroll") for (int i = 0; i < 16; ++i) { s0[i] += dl; s1[i] += dl; } } } \
            { const LAS unsigned char* kb_ = buf + ((t + 1) % KSL) * KS; nref = cref; \
              { const bf16x8 q_ = qpark[0]; if (MODE) { const float c_ = bfar - cref; _Pragma("unroll") for (int i = 0; i < 16; ++i) { n0[i] = c_; n1[i] = c_; } n0 = MFMA32(lfrag(kb_ + koff(0)), q_, n0); n1 = MFMA32(lfrag(kb_ + 4096 + koff(0)), q_, n1); } \
                else { n0 = MFMA32(lfrag(kb_ + koff(0)), q_, cv); n1 = MFMA32(lfrag(kb_ + 4096 + koff(0)), q_, cv); } } \
              _Pragma("unroll") for (int ds = 1; ds < 4; ++ds) { const bf16x8 q_ = qpark[ds * 64]; n0 = MFMA32(lfrag(kb_ + koff(ds)), q_, n0); n1 = MFMA32(lfrag(kb_ + 4096 + koff(ds)), q_, n1); } } \
            AT_PV(t - 1); \
            { float ls = 0.f; \
              if (!MODE) { const unsigned long long mw = mcur >> (8 * half); const unsigned mlo = (unsigned)mw, mhi = (unsigned)(mw >> 32); \
                _Pragma("unroll") for (int i = 0; i < 16; ++i) { const int bitp = 16 * (i >> 3) + (i & 7); \
                    const float p0 = __uint_as_float(__float_as_uint(fexp2(s0[i])) & bitmask1(mlo, bitp)); const float p1 = __uint_as_float(__float_as_uint(fexp2(s1[i])) & bitmask1(mhi, bitp)); \
                    s0[i] = p0; s1[i] = p1; ls += p0 + p1; } \
              } else { _Pragma("unroll") for (int i = 0; i < 16; ++i) { s0[i] = fexp2(s0[i]); s1[i] = fexp2(s1[i]); ls += s0[i] + s1[i]; } } \
              l_run += ls; } \
            pf0 = pack8(s0, 0); pf1 = pack8(s0, 1); pf2 = pack8(s1, 0); pf3 = pack8(s1, 1); \
            mtn = fmaxf(max16(n0), max16(n1)); mtn = fmaxf(mtn, xhalf(mtn)) + nref; \
            if (resc) { _Pragma("unroll") for (int d = 0; d < NDB; ++d) _Pragma("unroll") for (int i = 0; i < 16; ++i) O[d][i] *= alpha; } \
        AT_TAIL() } while (0)
    {
        const int tfe = (qw >= 154 + 128 && !ATP) ? (qw - 154) / 64 : 1;
        int t = 0;
        for (; t < 1; ++t) AT_STEP_G();
        for (; t < tfe; ++t) AT_STEP_F();
        for (; t < nt; ++t) AT_STEP_G();
    }
#undef AT_HEAD
#undef AT_TAIL
#undef AT_STEP_G
#undef AT_STEP_F
#undef AT_SOFTMAX
#undef AT_SETREF
    if (ntw == nt) AT_PV(nt - 1);
#undef AT_KLOAD
#undef AT_VLOAD
#undef AT_DMA
#undef AT_PRIO
#undef AT_QK
#undef AT_PV
#undef koff
#undef voff
    const float inv = frcp(l_run + xhalf(l_run));
    if (!MODE) {
        LAS unsigned char* xs = (LAS unsigned char*)(F.lds + BT + 1024 + wave * 4096);
#pragma unroll
        for (int db = 0; db < 2; ++db)
#pragma unroll
            for (int g = 0; g < 4; ++g) { u32x2 w; w.x = cvtpk(O[db][4 * g] * inv, O[db][4 * g + 1] * inv); w.y = cvtpk(O[db][4 * g + 2] * inv, O[db][4 * g + 3] * inv);
                *(LAS u32x2*)(xs + r32 * 128 + (((4 * db + g) ^ (r32 & 7)) << 4) + 8 * half) = w; }
#pragma unroll
        for (int i = 0; i < 4; ++i) { const int row = (lane >> 3) + 8 * i, ch = lane & 7;
            const u32x4 t = *(const LAS u32x4*)(xs + row * 128 + ((ch ^ (row & 7)) << 4));
            *(GAS u32x4*)(OUT + (size_t)(tokb + qw + row) * 512 + h * 64 + ch * 8) = t; }
        __syncthreads();
    } else {
        const float la = lamp[lane] * lamp[64 + lane], lb = lamp[128 + lane] * lamp[192 + lane];
        const float lam = __expf(wave_sum(la)) - __expf(wave_sum(lb)) + lam_init;
        __syncthreads();
        LAS float* ex = (LAS float*)(F.lds + wq * 16384);
        if (map == 1) {
            const float f = lam * inv;
#pragma unroll
            for (int db = 0; db < NDB; ++db)
#pragma unroll
                for (int i = 0; i < 16; ++i) ex[(db * 16 + i) * 64 + lane] = O[db][i] * f;
        }
        __syncthreads();
        if (map == 0) {
            float ss = 0.f;
#pragma unroll
            for (int db = 0; db < NDB; ++db)
#pragma unroll
                for (int i = 0; i < 16; ++i) { const float o = O[db][i] * inv - ex[(db * 16 + i) * 64 + lane]; O[db][i] = o; ss += o * o; }
            ss += xhalf(ss);
            const float rs = (1.0f / sqrtf(ss * (1.f / 128.f) + 1e-5f)) * (1.0f - lam_init);
            LAS unsigned char* xs = (LAS unsigned char*)ex;
#pragma unroll
            for (int db = 0; db < NDB; ++db)
#pragma unroll
                for (int g = 0; g < 4; ++g) { const f32x4 sg = *(const GAS f32x4*)(subg + 32 * db + 8 * g + 4 * half);
                    u32x2 w; w.x = cvtpk(O[db][4 * g] * rs * sg.x, O[db][4 * g + 1] * rs * sg.y); w.y = cvtpk(O[db][4 * g + 2] * rs * sg.z, O[db][4 * g + 3] * rs * sg.w);
                    *(LAS u32x2*)(xs + r32 * 256 + (((4 * db + g) ^ (r32 & 7)) << 4) + 8 * half) = w; }
#pragma unroll
            for (int i = 0; i < 8; ++i) { const int row = (lane >> 4) + 4 * i, ch = lane & 15;
                const u32x4 t = *(const LAS u32x4*)(xs + row * 256 + ((ch ^ (row & 7)) << 4));
                *(GAS u32x4*)(OUT + (size_t)(tokb + qw + row) * 512 + h * 128 + ch * 8) = t; }
        }
        __syncthreads();
    }
}

constexpr float SB_STOP = 48.f;
__device__ __forceinline__ void sb_unit(Frame& F, int b, int h, int qb, const bf16_t* PROJ_, const bf16_t* VT_, bf16_t* OC_) {
    const GAS bf16_t* PROJ = (const GAS bf16_t*)PROJ_;
    const GAS bf16_t* VT = (const GAS bf16_t*)VT_;
    GAS bf16_t* OC = (GAS bf16_t*)OC_;
    THREAD_IDS(); const int r32 = lane & 31, half = lane >> 5;
    LAS unsigned char* buf = F.lds; volatile LAS int* done_it = (volatile LAS int*)(F.lds + 32768);
    const int tokb = b * SEQ, qw = qb * 256 + 32 * wave, td = qw >> 6, tmax = 4 * qb + 3, qrel = (qw & 63) + r32;
    if (tid < 8) done_it[tid] = 0x7fffffff;
    bf16x8 qf[4];
#pragma unroll
    for (int ds = 0; ds < 4; ++ds) qf[ds] = *(const GAS bf16x8*)(PROJ + (size_t)(tokb + qw + r32) * NP + C_QC + h * 64 + 16 * ds + 8 * half);
    const int prow = pi_perm(r32), swk = (prow >> 1) & 7, swv = (r32 >> 1) & 7;
    int koff[4], voff[4];
#pragma unroll
    for (int k = 0; k < 4; ++k) { koff[k] = prow * 128 + (((2 * k + half) ^ swk) << 4); voff[k] = 8192 + r32 * 128 + (((2 * k + half) ^ swv) << 4); }
    const GAS bf16_t* kg = PROJ + (size_t)tokb * NP + C_KC + h * 64;
    const GAS bf16_t* vg = VT + (size_t)(1024 + h * 64) * VTP + tokb;
    float carry = 0.f; bool done = false; f32x16 O[2];
#pragma unroll
    for (int i = 0; i < 16; ++i) { O[0][i] = 0.f; O[1][i] = 0.f; }
    u32x4 kreg = tile_gload(kg + (size_t)tmax * 64 * NP, NP, tid), vreg = tile_gload(vg + tmax * 64, VTP, tid);
    *(LAS u32x4*)(buf + tid * 16) = kreg; *(LAS u32x4*)(buf + 8192 + tid * 16) = vreg;
    __syncthreads();
    for (int k = 0; k <= tmax; ++k) {
        const int t = tmax - k;
        const LAS unsigned char* cur = buf + (k & 1) * 16384;
        if (t > 0) { kreg = tile_gload(kg + (size_t)(t - 1) * 64 * NP, NP, tid); vreg = tile_gload(vg + (t - 1) * 64, VTP, tid); }
        if (t <= td && !done) {
            f32x16 z0, z1;
#pragma unroll
            for (int i = 0; i < 16; ++i) { z0[i] = 0.f; z1[i] = 0.f; }
#pragma unroll
            for (int ds = 0; ds < 4; ++ds) { z0 = MFMA32(lfrag(cur + koff[ds]), qf[ds], z0); z1 = MFMA32(lfrag(cur + 4096 + koff[ds]), qf[ds], z1); }
            if (t == td) {
                const float limf = (float)(qrel - 8 * half);
#pragma unroll
                for (int i = 0; i < 16; ++i) { const float o = (float)(16 * (i >> 3) + (i & 7)) + 0.5f;
                    z0[i] = fmaf(fminf(limf - o, 0.f), 1e30f, z0[i]); z1[i] = fmaf(fminf(limf - (o + 32.f), 0.f), 1e30f, z1[i]); }
            }
            f32x16 c0, c1;
#pragma unroll
            for (int i = 0; i < 16; ++i) {
                c0[i] = fmaxf(z0[i], 0.f) + flog2(1.f + fexp2(-fabsf(z0[i]))); c1[i] = fmaxf(z1[i], 0.f) + flog2(1.f + fexp2(-fabsf(z1[i]))); }
            float run[4];
#pragma unroll
            for (int s = 0; s < 2; ++s) { float a = 0.f, bb = 0.f;
#pragma unroll
                for (int i = 7; i >= 0; --i) { a += c0[8 * s + i]; c0[8 * s + i] = a; bb += c1[8 * s + i]; c1[8 * s + i] = bb; }
                run[s] = a; run[2 + s] = bb; }
            float off[4]; float after = carry;
#pragma unroll
            for (int q = 3; q >= 0; --q) { const float xr = xhalf(run[q]); off[q] = after + (half ? 0.f : xr); after += run[q] + xr; }
            carry = after;
#pragma unroll
            for (int i = 0; i < 16; ++i) { const int s = i >> 3; z0[i] = fexp2(z0[i] - (c0[i] + off[s])); z1[i] = fexp2(z1[i] - (c1[i] + off[2 + s])); }
            const bf16x8 pf0 = pack8(z0, 0), pf1 = pack8(z0, 1), pf2 = pack8(z1, 0), pf3 = pack8(z1, 1);
#pragma unroll
            for (int db = 0; db < 2; ++db) {
                O[db] = MFMA32(lfrag(cur + db * 4096 + voff[0]), pf0, O[db]); O[db] = MFMA32(lfrag(cur + db * 4096 + voff[1]), pf1, O[db]);
                O[db] = MFMA32(lfrag(cur + db * 4096 + voff[2]), pf2, O[db]); O[db] = MFMA32(lfrag(cur + db * 4096 + voff[3]), pf3, O[db]); }
            if (t == 0 || __all(carry > SB_STOP)) { done = true; if (lane == 0) done_it[wave] = k; }
        }
        if (t > 0) { LAS unsigned char* nb = buf + ((k + 1) & 1) * 16384; *(LAS u32x4*)(nb + tid * 16) = kreg; *(LAS u32x4*)(nb + 8192 + tid * 16) = vreg; }
        __syncthreads();
        bool all = true;
#pragma unroll
        for (int w = 0; w < 8; ++w) all = all && (done_it[w] <= k);
        if (all) break;
    }
    LAS unsigned char* xs = (LAS unsigned char*)(F.lds + 36864 + wave * 4096);
#pragma unroll
    for (int db = 0; db < 2; ++db)
#pragma unroll
        for (int g = 0; g < 4; ++g) { u32x2 w; w.x = cvtpk(O[db][4 * g], O[db][4 * g + 1]); w.y = cvtpk(O[db][4 * g + 2], O[db][4 * g + 3]);
            *(LAS u32x2*)(xs + r32 * 128 + (((4 * db + g) ^ (r32 & 7)) << 4) + 8 * half) = w; }
#pragma unroll
    for (int i = 0; i < 4; ++i) { const int row = (lane >> 3) + 8 * i, ch = lane & 7;
        const u32x4 t = *(const LAS u32x4*)(xs + row * 128 + ((ch ^ (row & 7)) << 4));
        *(GAS u32x4*)(OC + (size_t)(tokb + qw + row) * 512 + h * 64 + ch * 8) = t; }
    __syncthreads();
}

#ifdef PROBE_LAYER
constexpr int NSAMP = 96;
__device__ __forceinline__ float bfv(const bf16_t* p) { return __uint_as_float(((unsigned)*p) << 16); }
__device__ float blk_max(float v, float* red) { __syncthreads(); red[threadIdx.x] = v; __syncthreads(); for (int s = 256; s > 0; s >>= 1) { if ((int)threadIdx.x < s) red[threadIdx.x] = fmaxf(red[threadIdx.x], red[threadIdx.x + s]); __syncthreads(); } const float r = red[0]; __syncthreads(); return r; }
__global__ void __launch_bounds__(512) oracle_kernel(const unsigned char* ws, const float* rel_bias, const float* lamp, const float* subg, float lam_init) {
    __shared__ float sc[4096]; __shared__ unsigned char sel[4096]; __shared__ float red[512]; __shared__ float ssq[4];
    const int samp = blockIdx.x, tid = threadIdx.x;
    const int b = samp & 3, t = (samp * 1597 + 41) & 4095, tok = b * SEQ + t, ci = t >> 6, limit = 64 * (ci + 1);
    const bf16_t* PROJ = (const bf16_t*)(ws + WS_PROJ); const bf16_t* VT = (const bf16_t*)(ws + WS_VT); const float* WI = (const float*)(ws + WS_WI);
    unsigned* errw = (unsigned*)(ws + WS_CTL + 32768);
    {
        for (int s = tid; s < limit; s += 512) { float tot = 0.f;
            for (int h = 0; h < 4; ++h) { float d = 0.f; for (int k = 0; k < 64; ++k) d += bfv(PROJ + (size_t)tok * NP + C_QI + h * 64 + k) * bfv(PROJ + (size_t)(b * SEQ + s) * NP + C_KI + k);
                tot += WI[(size_t)tok * 4 + h] * fmaxf(d, 0.f); }
            sc[s] = tot + 0.0f; }
        __syncthreads();
        const int topk = limit < 256 ? limit : 256;
        for (int s = tid; s < limit; s += 512) { const float v = sc[s]; int rank = 0; for (int j = 0; j < limit; ++j) { const float u = sc[j]; rank += (u > v || (u == v && j < s)) ? 1 : 0; } sel[s] = rank < topk ? 1 : 0; }
        __syncthreads();
        const int h = tid >> 6, d = tid & 63;
        float mx = -INFINITY;
        for (int s = 0; s < limit; ++s) if (sel[s]) { float lg = 0.f; for (int k = 0; k < 64; ++k) lg += bfv(PROJ + (size_t)tok * NP + C_QA + h * 64 + k) * bfv(PROJ + (size_t)(b * SEQ + s) * NP + C_KA + h * 64 + k);
            lg += rel_bias[t5_bucket(s - t) * 12 + h] * LOG2E; mx = fmaxf(mx, lg); }
        float l = 0.f, o = 0.f;
        for (int s = 0; s < limit; ++s) if (sel[s]) { float lg = 0.f; for (int k = 0; k < 64; ++k) lg += bfv(PROJ + (size_t)tok * NP + C_QA + h * 64 + k) * bfv(PROJ + (size_t)(b * SEQ + s) * NP + C_KA + h * 64 + k);
            lg += rel_bias[t5_bucket(s - t) * 12 + h] * LOG2E; const float p = exp2f(lg - mx); l += p; o += p * bfv(VT + (size_t)(h * 64 + d) * VTP + b * SEQ + s); }
        o /= l;
        const float mine = bfv((const bf16_t*)(ws + WS_OA) + (size_t)tok * 512 + tid);
        const float md = blk_max(fabsf(o - mine), red), ma = blk_max(fabsf(o), red);
        if (tid == 0) atomicMax(errw + 0, __float_as_uint(md / fmaxf(ma, 1e-20f)));
    }
    {
        const int h = tid >> 7, e = tid & 127; float on0 = 0.f, on1 = 0.f;
        for (int m = 0; m < 2; ++m) {
            float mx = -INFINITY;
            for (int s = 0; s < limit; ++s) { float lg = 0.f; for (int k = 0; k < 64; ++k) lg += bfv(PROJ + (size_t)tok * NP + C_QB + h * 128 + m * 64 + k) * bfv(PROJ + (size_t)(b * SEQ + s) * NP + C_KB + h * 128 + m * 64 + k);
                lg += rel_bias[t5_bucket(s - t) * 12 + 8 + h] * LOG2E; mx = fmaxf(mx, lg); }
            float l = 0.f, o = 0.f;
            for (int s = 0; s < limit; ++s) { float lg = 0.f; for (int k = 0; k < 64; ++k) lg += bfv(PROJ + (size_t)tok * NP + C_QB + h * 128 + m * 64 + k) * bfv(PROJ + (size_t)(b * SEQ + s) * NP + C_KB + h * 128 + m * 64 + k);
                lg += rel_bias[t5_bucket(s - t) * 12 + 8 + h] * LOG2E; const float p = exp2f(lg - mx); l += p; o += p * bfv(VT + (size_t)(512 + h * 128 + e) * VTP + b * SEQ + s); }
            if (m == 0) on0 = o / l; else on1 = o / l;
        }
        float la = 0.f, lb = 0.f; for (int k = 0; k < 64; ++k) { la += lamp[k] * lamp[64 + k]; lb += lamp[128 + k] * lamp[192 + k]; }
        const float lam = expf(la) - expf(lb) + lam_init;
        float o = on0 - lam * on1;
        if (tid < 4) ssq[tid] = 0.f; __syncthreads(); atomicAdd(&ssq[h], o * o); __syncthreads();
        o = o * rsqrtf(ssq[h] / 128.f + 1e-5f) * subg[e] * (1.0f - lam_init);
        const float mine = bfv((const bf16_t*)(ws + WS_OB) + (size_t)tok * 512 + tid);
        const float md = blk_max(fabsf(o - mine), red), ma = blk_max(fabsf(o), red);
        if (tid == 0) atomicMax(errw + 1, __float_as_uint(md / fmaxf(ma, 1e-20f)));
    }
    {
        const int h = tid >> 6, d = tid & 63; float C = 0.f, o = 0.f;
        for (int s = t - 1; s >= 0; --s) { float z = 0.f; for (int k = 0; k < 64; ++k) z += bfv(PROJ + (size_t)tok * NP + C_QC + h * 64 + k) * bfv(PROJ + (size_t)(b * SEQ + s) * NP + C_KC + h * 64 + k);
            const float sp = fmaxf(z, 0.f) + log2f(1.f + exp2f(-fabsf(z))); C += sp; o += exp2f(z - C) * bfv(VT + (size_t)(1024 + h * 64 + d) * VTP + b * SEQ + s); }
        const float mine = bfv((const bf16_t*)(ws + WS_OC) + (size_t)tok * 512 + tid);
        const float md = blk_max(fabsf(o - mine), red), ma = blk_max(fabsf(o), red);
        if (tid == 0) atomicMax(errw + 2, __float_as_uint(md / fmaxf(ma, 1e-20f)));
    }
}
#ifndef PROBE_SEL
#define PROBE_SEL -1
#endif
__global__ void probe_out_kernel(const unsigned char* ws, float* out, int n) {
    const unsigned* errw = (const unsigned*)(ws + WS_CTL + 32768);
    float v;
    if (PROBE_SEL < 0) { int code = 0; for (int k = 0; k < 3; ++k) { const float e = __uint_as_float(errw[k]); if (!(e < 0.03f)) code |= 1 << k; } v = 20.f + 8.f * code; }
    else v = 20.f + 1e4f * __uint_as_float(errw[PROBE_SEL]);
    const float c = sqrtf(v);
    for (int i = blockIdx.x * blockDim.x + threadIdx.x; i < n; i += gridDim.x * blockDim.x) out[i] = c;
}
#endif

constexpr int LDS_BYTES = 155648;
constexpr int MISC_OFF = LDS_BYTES - 1024;
constexpr int NPH_LAYER = 13, NPHASES = 1 + 2 * NPH_LAYER;

#define IN(i) karg_in(i)
#define WSP(off) wsp(F.ws, (off))
#ifndef LBW
#define LBW 2
#endif
__global__ void __launch_bounds__(NTHREADS, LBW) fwd_kernel(Args args_unused) {
    extern __shared__ __attribute__((aligned(16))) unsigned char lds_raw[];
    Frame F;
    F.lds = (LAS unsigned char*)lds_raw;
    F.G = gridDim.x; F.bx = blockIdx.x; F.vcu = (F.bx % 8) * (F.G / 8) + F.bx / 8; F.ws = (unsigned char*)karg_in(22);
    unsigned* ctl = (unsigned*)(F.ws + WS_CTL);
    if (threadIdx.x < 4) ((LAS unsigned*)(F.lds + MISC_OFF))[threadIdx.x] = 0u;
    __syncthreads();
    const int lo = karg_int(46), hi = karg_int(47);
    const bool one_launch = (hi - lo) > 1;
    XcdBarrier bar; bar.bar = ctl + CW_BAR; bar.x = 0; bar.st = nullptr;
    if (one_launch) bar = xcd_barrier_post(ctl + CW_BAR, (volatile LAS unsigned*)(F.lds + MISC_OFF));
#ifndef ONLY_PH
#define ONLY_PH -1
#endif
#define PHEN(k) (ONLY_PH < 0 || ONLY_PH == (k))
#define RUN(id) (lo <= (id) && (id) < hi)
#define RUNK(k) (PHEN(k) && RUN(pb + (k)))
#ifndef ORD_P1
#define ORD_P1 0
#endif
#ifndef ORD_P7
#define ORD_P7 0
#endif
#ifndef ORD_P10
#define ORD_P10 0
#endif
#ifndef ORD_P11
#define ORD_P11 0
#endif
#ifndef DUP_PH
#define DUP_PH -1
#endif
#ifndef DUP_L
#define DUP_L -1
#endif
#define REP(k) for (int rep_ = 0; rep_ < (((DUP_PH) == (k) && (DUP_L < 0 || DUP_L == l_rep_)) ? 2 : 1); ++rep_)
#ifdef TIMER_PH
#ifndef TIMER_L
#define TIMER_L 0
#endif
#define SEAM(id) do { if ((id) + 1 < hi) xcd_barrier(bar); \
        if ((id) == 1 + NPH_LAYER * TIMER_L + TIMER_PH && blockIdx.x == 0 && threadIdx.x == 0) ctl[16] = (unsigned)wall_clock64() - ctl[17]; } while (0)
#define TSTART(k) do { if ((k) == TIMER_PH && l == TIMER_L && blockIdx.x == 0 && threadIdx.x == 0) ctl[17] = (unsigned)wall_clock64(); } while (0)
#else
#define SEAM(id) do { if ((id) + 1 < hi) xcd_barrier(bar); } while (0)
#define TSTART(k) do { } while (0)
#endif

    if (PHEN(100) && RUN(0)) { const int l_rep_ = 0; (void)l_rep_; REP(100) { p0_prologue(F); __syncthreads(); } SEAM(0); }

    for (int l = 0; l < DEPTH; ++l) {
        const int pb = 1 + NPH_LAYER * l; const int l_rep_ = l; (void)l_rep_;
#define MODL(k) ((const float*)WSP(WS_MOD) + (size_t)l * 4 * 6144 + (k) * D)
#define XCUR() ((l == 0) ? IN(0) : (const float*)IN(21))
#define XRES() ((float*)IN(21))
        if (RUNK(0)) { TSTART(0); norm_phase<false>(F, XCUR(), IN(4) + l * D, MODL(0), MODL(1), (bf16_t*)WSP(WS_XN), nullptr, nullptr); SEAM(pb + 0); }
        if (RUNK(1)) { TSTART(1); REP(1) {
#ifdef STAGGER_US10
            {
                const unsigned long long t0_ = __builtin_amdgcn_s_memrealtime(); const unsigned long long dl_ = (unsigned long long)((F.bx >> 3) & 31) * STAGGER_US10 * 10ull;
                while (__builtin_amdgcn_s_memrealtime() - t0_ < dl_) __builtin_amdgcn_s_sleep(8);
            }
#endif
#ifdef INPROJ_ONLY
            if (!(rep_ == 0 && INPROJ_ONLY == 2))
#endif
            { pg8::Gemm g{D, D, D}; TileSched S; S.init(WS_XN, WS_WIN + (size_t)l * 13 * MiB, T, NPROJ, D, D, F.G, F.bx); S.ord = ORD_P1;
#ifdef INPROJ_ABL
#if INPROJ_ABL == 2
              if (rep_ == 0) { EpiBf16 E0{(bf16_t*)WSP(WS_PROJ), NP}; fill_units(F.lds, S); pg8::gemm_phase(F.lds, (const char*)F.ws, g, E0); } else
#elif INPROJ_ABL == 3
              if (rep_ == 0) { EpiBlocked E0{(bf16_t*)WSP(WS_PROJ)}; fill_units(F.lds, S); pg8::gemm_phase(F.lds, (const char*)F.ws, g, E0); xcd_barrier(bar); } else
#else
              if (rep_ == 0) { EpiLinear E0{(bf16_t*)WSP(WS_PROJ)}; fill_units(F.lds, S); pg8::gemm_phase(F.lds, (const char*)F.ws, g, E0); } else
#endif
#endif
              { EpiProj E{(bf16_t*)WSP(WS_PROJ), (float*)WSP(WS_WI), F.lds}; fill_units(F.lds, S); pg8::gemm_phase(F.lds, (const char*)F.ws, g, E); } }
#ifdef INPROJ_ONLY
            if (!(rep_ == 0 && INPROJ_ONLY == 1))
#endif
            { pg8::Gemm g{D, D, D}; TileSched S; S.init(WS_WV + (size_t)l * 3 * MiB, WS_XN, 1536, T, D, D, F.G, (F.bx + 128) & 255);
              EpiBf16 E{(bf16_t*)WSP(WS_VT), VTP, F.lds}; fill_units(F.lds, S); pg8::gemm_phase(F.lds, (const char*)F.ws, g, E); }
            }
            SEAM(pb + 1);
        }
        if (RUNK(2)) { TSTART(2); REP(2) {
            const int c = F.vcu, b = c >> 6, m = c & 63;
            const bf16_t* PROJ = (const bf16_t*)WSP(WS_PROJ); const float* WI = (const float*)WSP(WS_WI); unsigned long long* MASK = (unsigned long long*)WSP(WS_MASK);
            for (int k = 0; k < 8; ++k) { const int ci = 8 * k + ((k & 1) ? 7 - (m & 7) : (m & 7)); topk_unit(F, b, ci, m >> 3, PROJ, WI, MASK); }
            }
        }
        if (RUNK(3)) { TSTART(3); REP(3) {
            const int c = F.vcu, bh = c >> 4, s = c & 15; const float lam_init = 0.8f - 0.6f * __expf(-0.3f * (float)l);
            const bool hiw = (__builtin_amdgcn_readfirstlane((int)threadIdx.x >> 6) & 1) != 0;
            for (int k = 0; k < 2; ++k) { if (!hiw) attn_unit<1, 0>(F, bh >> 2, bh & 3, k == 0 ? s : 31 - s, (const bf16_t*)WSP(WS_PROJ), (const bf16_t*)WSP(WS_VT), nullptr, (bf16_t*)WSP(WS_OB), IN(9), IN(10) + l * 256, IN(11) + l * 128, lam_init); else attn_unit<1, 1>(F, bh >> 2, bh & 3, k == 0 ? s : 31 - s, (const bf16_t*)WSP(WS_PROJ), (const bf16_t*)WSP(WS_VT), nullptr, (bf16_t*)WSP(WS_OB), IN(9), IN(10) + l * 256, IN(11) + l * 128, lam_init); }
            }
        }
        if (RUNK(4)) { TSTART(4); REP(4) {
            const int c = F.vcu, bh = c >> 3, s = c & 7;
            for (int k = 0; k < 2; ++k) sb_unit(F, bh >> 3, bh & 7, k == 0 ? s : 15 - s, (const bf16_t*)WSP(WS_PROJ), (const bf16_t*)WSP(WS_VT), (bf16_t*)WSP(WS_OC));
            }
            SEAM(pb + 4);
        }
        if (RUNK(5)) { TSTART(5); REP(5) {
            const int c = F.vcu, bh = c >> 3, s = c & 7;
            const bool hiw = (__builtin_amdgcn_readfirstlane((int)threadIdx.x >> 6) & 1) != 0;
#ifdef ATP_PROBE
                        for (int k = 0; k < 2; ++k) { if (!hiw) attn_unit<0, 0, ATP_PROBE>(F, bh >> 3, bh & 7, k == 0 ? s : 15 - s, (const bf16_t*)WSP(WS_PROJ), (const bf16_t*)WSP(WS_VT), (const unsigned long long*)WSP(WS_MASK), (bf16_t*)WSP(WS_OA), IN(9), nullptr, nullptr, 0.f); else attn_unit<0, 1, ATP_PROBE>(F, bh >> 3, bh & 7, k == 0 ? s : 15 - s, (const bf16_t*)WSP(WS_PROJ), (const bf16_t*)WSP(WS_VT), (const unsigned long long*)WSP(WS_MASK), (bf16_t*)WSP(WS_OA), IN(9), nullptr, nullptr, 0.f); }
#endif
            for (int k = 0; k < 2; ++k) { if (!hiw) attn_unit<0, 0>(F, bh >> 3, bh & 7, k == 0 ? s : 15 - s, (const bf16_t*)WSP(WS_PROJ), (const bf16_t*)WSP(WS_VT), (const unsigned long long*)WSP(WS_MASK), (bf16_t*)WSP(WS_OA), IN(9), nullptr, nullptr, 0.f); else attn_unit<0, 1>(F, bh >> 3, bh & 7, k == 0 ? s : 15 - s, (const bf16_t*)WSP(WS_PROJ), (const bf16_t*)WSP(WS_VT), (const unsigned long long*)WSP(WS_MASK), (bf16_t*)WSP(WS_OA), IN(9), nullptr, nullptr, 0.f); }

            }
            SEAM(pb + 5);
        }
        if (RUNK(6)) { TSTART(6);
            pg8::Gemm g{512, 512, 512}; BranchSched S; S.B = (unsigned)(WS_WBR + (size_t)l * 3 * MiB); S.c = F.bx;
            EpiBranch E{(const bf16_t*)WSP(WS_PROJ) + C_GATE, (bf16_t*)WSP(WS_MERGED), F.lds}; fill_units(F.lds, S); pg8::gemm_phase(F.lds, (const char*)F.ws, g, E);
            SEAM(pb + 6);
        }
        if (RUNK(7)) { TSTART(7);
            pg8::Gemm g{D, D, D}; TileSched S; S.init(WS_MERGED, WS_WOUT + (size_t)l * 2 * MiB, T, D, D, D, F.G, F.bx); S.ord = ORD_P7;
            EpiResid E{XCUR(), XRES(), MODL(2), F.lds}; fill_units(F.lds, S); pg8::gemm_phase(F.lds, (const char*)F.ws, g, E);
            SEAM(pb + 7);
        }
        if (l == 0) {
            if (RUNK(8)) { TSTART(8); norm_phase<false>(F, XRES(), IN(5) + l * D, MODL(3), MODL(4), (bf16_t*)WSP(WS_XN), nullptr, nullptr); SEAM(pb + 8); }
            if (RUNK(10)) { TSTART(10); REP(10) {
                pg8::Gemm g{D, D, D}; TileSched S; S.init(WS_XN, WS_W13, T, 2 * DFF, D, D, F.G, F.bx); S.ord = ORD_P10;
                EpiSwiGLU E{(bf16_t*)WSP(WS_HID), DFF}; fill_units(F.lds, S); pg8::gemm_phase(F.lds, (const char*)F.ws, g, E);
                }
                SEAM(pb + 10);
            }
            if (RUNK(11)) { TSTART(11); REP(111) {
                pg8::Gemm g{DFF, DFF, DFF}; TileSched S; S.init(WS_HID, WS_W2, T, D, DFF, DFF, F.G, F.bx); S.ord = ORD_P11;
                EpiResid E{XRES(), XRES(), MODL(5), F.lds}; fill_units(F.lds, S); pg8::gemm_phase<EpiResid, false, true>(F.lds, (const char*)F.ws, g, E);
                }
                SEAM(pb + 11);
            }
        } else {
            if (RUNK(8)) { TSTART(8); norm_phase<true>(F, XRES(), IN(5) + l * D, MODL(3), MODL(4), (bf16_t*)WSP(WS_XN), IN(15), IN(16)); SEAM(pb + 8); }
            if (RUNK(9)) { TSTART(9); moe_gather_phase(F, (const bf16_t*)WSP(WS_XN), (bf16_t*)WSP(WS_XP)); SEAM(pb + 9); }
            if (RUNK(10)) { TSTART(10); REP(10) {
                pg8::Gemm g{D, D, D}; MoeSched S{(unsigned)WS_XP, (unsigned)WS_MW13, (const int*)WSP(WS_TILETAB), 256u * D * 2, 256u * D * 2, 2u * DFFE * D * 2, 2 * DFFE / 256, F.G, F.bx, 1, 0u, 0u};
#ifdef MOE_E0
                if (DUP_PH == 10 && rep_ == 0) S.estep = 0u;
#endif
#ifdef MOE_A0
                if (DUP_PH == 10 && rep_ == 0) S.astep = 0u;
#endif
                EpiSwiGLU E{(bf16_t*)WSP(WS_HID), DFFE}; fill_units(F.lds, S); pg8::gemm_phase(F.lds, (const char*)F.ws, g, E);
                }
                SEAM(pb + 10);
            }
            if (RUNK(11)) { TSTART(11); REP(11) {
                pg8::Gemm g{DFFE / 2, DFFE, DFFE}; MoeSched S{(unsigned)WS_HID, (unsigned)WS_MW2, (const int*)WSP(WS_TILETAB), 256u * DFFE * 2, 256u * DFFE * 2, (unsigned)D * DFFE * 2, D / 256, F.G, F.bx, 2, (unsigned)DFFE, (unsigned)(DFFE / 64) * 16384u};
                EpiBf16Split E{(bf16_t*)WSP(WS_XP), (bf16_t*)WSP(WS_MW13), D, F.lds}; fill_units(F.lds, S); pg8::gemm_phase<EpiBf16Split, false, true>(F.lds, (const char*)F.ws, g, E);
                }
                SEAM(pb + 11);
            }
            if (RUNK(12)) { TSTART(12); final_phase(F, XRES(), (const bf16_t*)WSP(WS_XP), (const bf16_t*)WSP(WS_MW13), MODL(5), IN(20)); }
        }
    }
#ifdef TIMER_PH
    {
        __syncthreads();
        const float us = (float)__hip_atomic_load(ctl + 16, __ATOMIC_RELAXED, __HIP_MEMORY_SCOPE_AGENT) * 0.01f; const float cst = logf(fmaxf(us, 1.0f));
        float* o = (float*)IN(21) + (size_t)blockIdx.x * 64 * D;
        for (int i = threadIdx.x; i < 64 * D; i += NTHREADS) o[i] = cst;
    }
#endif
#undef RUN
#undef SEAM
}

#include <cmath>
#ifndef N_LAUNCH_MODE
#define N_LAUNCH_MODE 1
#endif
extern "C" void kernel_launch(void* const* d_in, const int* in_sizes, int n_in, void* d_out, int out_size, void* d_ws, size_t ws_size, hipStream_t stream) {
    static int grid = 0;
    if (grid == 0) {
        if (n_in != 21 || in_sizes[0] != T * D || out_size != T * D || ws_size < WS_END) { fprintf(stderr, "kernel_launch: unexpected shapes / workspace (%d inputs, ws %zu < %zu)\n", n_in, ws_size, (size_t)WS_END); grid = -1; return; }
        int dev = 0, cus = 0, per_cu = 0;
        if (hipGetDevice(&dev) != hipSuccess || hipDeviceGetAttribute(&cus, hipDeviceAttributeMultiprocessorCount, dev) != hipSuccess) { grid = -1; return; }
        if (hipFuncSetAttribute((const void*)fwd_kernel, hipFuncAttributeMaxDynamicSharedMemorySize, LDS_BYTES) != hipSuccess) { fprintf(stderr, "kernel_launch: cannot get %d bytes of LDS\n", LDS_BYTES); grid = -1; return; }
        if (hipOccupancyMaxActiveBlocksPerMultiprocessor(&per_cu, (const void*)fwd_kernel, NTHREADS, LDS_BYTES) != hipSuccess || per_cu < 1) { fprintf(stderr, "kernel_launch: occupancy query says %d\n", per_cu); }
        (void)hipGetLastError();
        if (cus != 256) { fprintf(stderr, "kernel_launch: built for 256 CUs, found %d\n", cus); grid = -1; return; }
        grid = 256;
    }
    if (grid < 0) return;
    (void)hipMemsetAsync((char*)d_ws + WS_CTL, 0, CTL_ZERO_BYTES, stream);
    Args a{};
    for (int i = 0; i < 21; ++i) a.in[i] = (const float*)d_in[i];
    a.out = (float*)d_out; a.ws = (unsigned char*)d_ws;
#if defined(PROBE_LAYER)
    a.ph_lo = 0; a.ph_hi = 1 + NPH_LAYER * PROBE_LAYER + 6;
    hipLaunchKernelGGL(fwd_kernel, dim3(grid), dim3(NTHREADS), LDS_BYTES, stream, a);
    hipLaunchKernelGGL(oracle_kernel, dim3(NSAMP), dim3(512), 0, stream, (const unsigned char*)d_ws, (const float*)d_in[9], (const float*)d_in[10] + PROBE_LAYER * 256, (const float*)d_in[11] + PROBE_LAYER * 128, 0.8f - 0.6f * expf(-0.3f * (float)PROBE_LAYER));
    hipLaunchKernelGGL(probe_out_kernel, dim3(1024), dim3(256), 0, stream, (const unsigned char*)d_ws, (float*)d_out, out_size);
#elif N_LAUNCH_MODE == 1
    a.ph_lo = 0; a.ph_hi = NPHASES;
    hipLaunchKernelGGL(fwd_kernel, dim3(grid), dim3(NTHREADS), LDS_BYTES, stream, a);
#else
    for (int p = 0; p < NPHASES; ++p) {
        if (p == 1 + 9 || p == 1 + 12) continue;
        a.ph_lo = p; a.ph_hi = p + 1;
        hipLaunchKernelGGL(fwd_kernel, dim3(grid), dim3(NTHREADS), LDS_BYTES, stream, a);
    }
#endif
}
```

```cpp
#include <hip/hip_runtime.h>
#include <cstdio>
#include <cstdint>

#define LAS __attribute__((address_space(3)))
#define GAS __attribute__((address_space(1)))
typedef unsigned short bf16_t;
typedef short bf16x8 __attribute__((ext_vector_type(8)));
typedef float f32x2 __attribute__((ext_vector_type(2)));
typedef float f32x4 __attribute__((ext_vector_type(4)));
typedef float f32x16 __attribute__((ext_vector_type(16)));
typedef unsigned u32x2 __attribute__((ext_vector_type(2)));
typedef unsigned u32x4 __attribute__((ext_vector_type(4)));
typedef __bf16 bf16x2_t __attribute__((ext_vector_type(2)));

__device__ __forceinline__ unsigned cvtpk(float lo, float hi) { f32x2 v = {lo, hi}; bf16x2_t b = __builtin_convertvector(v, bf16x2_t); return __builtin_bit_cast(unsigned, b); }
__device__ __forceinline__ float bf_lo(unsigned w) { return __uint_as_float(w << 16); }
__device__ __forceinline__ float bf_hi(unsigned w) { return __uint_as_float(w & 0xffff0000u); }
__device__ __forceinline__ float fexp2(float x) { return __builtin_amdgcn_exp2f(x); }
__device__ __forceinline__ float flog2(float x) { return __builtin_amdgcn_logf(x); }
__device__ __forceinline__ float frcp(float x) { return __builtin_amdgcn_rcpf(x); }
__device__ __forceinline__ float wave_sum(float v) {
#pragma unroll
    for (int o = 1; o < 64; o <<= 1) v += __shfl_xor(v, o);
    return v;
}
__device__ __forceinline__ int wave_sum_i32(int v) {
    v += __builtin_amdgcn_update_dpp(0, v, 0x111, 0xf, 0xf, false);
    v += __builtin_amdgcn_update_dpp(0, v, 0x112, 0xf, 0xf, false);
    v += __builtin_amdgcn_update_dpp(0, v, 0x114, 0xf, 0xf, false);
    v += __builtin_amdgcn_update_dpp(0, v, 0x118, 0xf, 0xf, false);
    v += __builtin_amdgcn_update_dpp(0, v, 0x142, 0xa, 0xf, false);
    v += __builtin_amdgcn_update_dpp(0, v, 0x143, 0xc, 0xf, false);
    return __builtin_amdgcn_readlane(v, 63);
}
__device__ __forceinline__ unsigned wave_max_u32(unsigned v) {
#define WMX_(ctrl, rm) v = max(v, (unsigned)__builtin_amdgcn_update_dpp(0, (int)v, ctrl, rm, 0xf, false))
    WMX_(0x111, 0xf); WMX_(0x112, 0xf); WMX_(0x114, 0xf); WMX_(0x118, 0xf); WMX_(0x142, 0xa); WMX_(0x143, 0xc);
#undef WMX_
    return (unsigned)__builtin_amdgcn_readlane((int)v, 63);
}
__device__ __forceinline__ unsigned wave_min_u32(unsigned v) {
#define WMN_(ctrl, rm) v = min(v, (unsigned)__builtin_amdgcn_update_dpp(-1, (int)v, ctrl, rm, 0xf, false))
    WMN_(0x111, 0xf); WMN_(0x112, 0xf); WMN_(0x114, 0xf); WMN_(0x118, 0xf); WMN_(0x142, 0xa); WMN_(0x143, 0xc);
#undef WMN_
    return (unsigned)__builtin_amdgcn_readlane((int)v, 63);
}
__device__ __forceinline__ int wave_scan_i32(int v) {
    v += __builtin_amdgcn_update_dpp(0, v, 0x111, 0xf, 0xf, false);
    v += __builtin_amdgcn_update_dpp(0, v, 0x112, 0xf, 0xf, false);
    v += __builtin_amdgcn_update_dpp(0, v, 0x114, 0xf, 0xf, false);
    v += __builtin_amdgcn_update_dpp(0, v, 0x118, 0xf, 0xf, false);
    v += __builtin_amdgcn_update_dpp(0, v, 0x142, 0xa, 0xf, false);
    v += __builtin_amdgcn_update_dpp(0, v, 0x143, 0xc, 0xf, false);
    return v;
}
__device__ __forceinline__ int otid() { int t = threadIdx.x; asm volatile("" : "+v"(t)); return t; }
__device__ __forceinline__ float xhalf(float v) {
    auto rr = __builtin_amdgcn_permlane32_swap(__float_as_uint(v), __float_as_uint(v), false, false);
    return (threadIdx.x & 32) ? __uint_as_float(rr[0]) : __uint_as_float(rr[1]);
}

namespace pg8 {
constexpr int BM = 256, BK = 64, HALF = 128, HTB = HALF * BK * 2, STAGE_BYTES = 8 * HTB, NXCD = 8, WGM = 8;
__host__ __device__ __forceinline__ int lds_byte(int r, int c) { const int st = (r >> 4) * 2 + (c >> 5), rr = r & 15, cc = c & 31, ob = rr * 64 + cc * 2; return st * 1024 + (ob ^ (((ob >> 9) & 1) << 5)); }
__host__ __device__ __forceinline__ void stage_rc(int b, int& R, int& C) { const int st = b / 1024, sb = b % 1024, swz = sb ^ (((sb >> 9) & 1) << 5); R = (st >> 1) * 16 + swz / 64; C = (st & 1) * 32 + (swz % 64) / 2; }
__host__ __device__ __forceinline__ int perm32(int rho) { const int n = rho >> 4, i = rho & 15; return 8 * (i >> 2) + 4 * n + (i & 3); }

struct Unit { int pm, pn, aux; unsigned a, b; int nt; };
struct Gemm { int K, lda, ldb; };

constexpr int UT_OFF = 132096;
struct UnitTab {
    const LAS u32x4* ut;
    __device__ __forceinline__ bool next(int i, Unit& u) const {
        const u32x4 e = ut[i];
        const unsigned w = __builtin_amdgcn_readfirstlane(e.w);
        if (w == 0u) return false;
        u.nt = (int)(w & 0xffffu);
        u.a = __builtin_amdgcn_readfirstlane(e.x); u.b = __builtin_amdgcn_readfirstlane(e.y);
        const unsigned z = __builtin_amdgcn_readfirstlane(e.z); u.pm = z & 4095; u.pn = (z >> 12) & 4095; u.aux = z >> 24; return true;
    }
};
template <class Epi, bool VARK = false, bool ABLK = false>
__device__ __forceinline__ void gemm_phase(LAS unsigned char* lds, const char* base, const Gemm g, const Epi& E) {
    UnitTab S; S.ut = (const LAS u32x4*)(lds + UT_OFF);
    const int tid = otid(), wid = __builtin_amdgcn_readfirstlane(tid >> 6), lane = tid & 63, wr = wid >> 2, wc = wid & 3, fr = lane & 15, fq = lane >> 4;
    const int K = g.K, nt = K / BK;
    unsigned voffA[2], voffB[2];
#pragma unroll
    for (int i = 0; i < 2; ++i) { int R, C; stage_rc(tid * 16 + i * 8192, R, C); const int Rb = 64 * (R >> 5) + (Epi::PERM ? perm32(R & 31) : (R & 31));
        voffA[i] = ABLK ? (unsigned)((C >> 5) * 16384 + R * 64 + (C & 31) * 2) : (unsigned)(R * g.lda + C) * 2u; voffB[i] = (unsigned)(Rb * g.ldb + C) * 2u; }
    const size_t kstep = (size_t)(BK * 2), kstepA = ABLK ? (size_t)32768 : kstep;
    const unsigned hstepA = ABLK ? (unsigned)HALF * 64u : (unsigned)HALF * g.lda * 2, hstepB = 32u * g.ldb * 2;
    const unsigned ldsw = (unsigned)wid * 1024u;
    const int aoff = lds_byte(wr * 64 + fr, fq * 8), boff = lds_byte(wc * 32 + fr, fq * 8);
#define PG8_SA(b, h) (((b) * 2 + (h)) * HTB)
#define PG8_SB(b, h) ((4 + (b) * 2 + (h)) * HTB)
#define PG8_STAGE(bufoff, gbase, voff) do { _Pragma("unroll") for (int _i = 0; _i < 2; ++_i) \
        __builtin_amdgcn_global_load_lds((const unsigned*)((const char*)(gbase) + (voff)[_i]), (LAS unsigned*)(lds + (bufoff) + ldsw + _i * 8192), 16, 0, 0); } while (0)
#define PG8_LDA(dst, b, h) do { _Pragma("unroll") for (int m = 0; m < 4; ++m) _Pragma("unroll") for (int k = 0; k < 2; ++k) dst[m][k] = *(const LAS bf16x8*)(lds + PG8_SA(b, h) + aoff + m * 2048 + k * 1024); } while (0)
#define PG8_LDB(dst, b, h) do { _Pragma("unroll") for (int n = 0; n < 2; ++n) _Pragma("unroll") for (int k = 0; k < 2; ++k) dst[n][k] = *(const LAS bf16x8*)(lds + PG8_SB(b, h) + boff + n * 2048 + k * 1024); } while (0)
#define PG8_MMA(ai, bj, At, Bt) do { __builtin_amdgcn_s_setprio(1); _Pragma("unroll") for (int m = 0; m < 4; ++m) _Pragma("unroll") for (int n = 0; n < 2; ++n) _Pragma("unroll") for (int k = 0; k < 2; ++k) \
        acc[ai][bj][m][n] = __builtin_amdgcn_mfma_f32_16x16x32_bf16(Bt[n][k], At[m][k], acc[ai][bj][m][n], 0, 0, 0); __builtin_amdgcn_s_setprio(0); } while (0)
#define PG8_WAIT_V(n) asm volatile("s_waitcnt vmcnt(" #n ")" ::: "memory")
#define PG8_WAIT_L(n) asm volatile("s_waitcnt lgkmcnt(" #n ")" ::: "memory")
#define PG8_BAR __builtin_amdgcn_s_barrier()
#define PG8_SCHED __builtin_amdgcn_sched_barrier(0)
    Unit cur, nxt; int ui = 0;
    if (!S.next(0, cur)) return;
    f32x4 acc[2][2][4][2];
#pragma unroll
    for (int a = 0; a < 2; ++a)
#pragma unroll
        for (int b = 0; b < 2; ++b)
#pragma unroll
            for (int m = 0; m < 4; ++m)
#pragma unroll
                for (int n = 0; n < 2; ++n) acc[a][b][m][n] = (f32x4){0.f, 0.f, 0.f, 0.f};
    bf16x8 At[4][2], B0[2][2], B1[2][2];
    const char* cA = base + cur.a; const char* cB = base + cur.b;
    PG8_STAGE(PG8_SB(0, 0), cB, voffB); PG8_STAGE(PG8_SB(0, 1), cB + hstepB, voffB); PG8_STAGE(PG8_SA(0, 0), cA, voffA); PG8_STAGE(PG8_SA(0, 1), cA + hstepA, voffA);
    if (wr == 1) PG8_BAR;
    PG8_WAIT_V(2); PG8_BAR;
    PG8_STAGE(PG8_SB(1, 0), cB + kstep, voffB); PG8_STAGE(PG8_SA(1, 0), cA + kstepA, voffA); PG8_STAGE(PG8_SB(1, 1), cB + hstepB + kstep, voffB);
    PG8_WAIT_V(6); PG8_BAR;
    for (;;) {
        const bool has_next = S.next(ui + 1, nxt);
        const char* nA = has_next ? base + nxt.a : cA; const char* nB = has_next ? base + nxt.b : cB;
        const int ntu = VARK ? cur.nt : nt;
        for (int t = 0; t < ntu; t += 2) {
            const bool last = (t == ntu - 2);
            const char* a1 = cA + (size_t)(t + 1) * kstepA;
            const char* a2 = last ? nA : cA + (size_t)(t + 2) * kstepA; const char* b2 = last ? nB : cB + (size_t)(t + 2) * kstep;
            const char* a3 = a2 + kstepA; const char* b3 = b2 + kstep;
            PG8_LDB(B0, 0, 0); PG8_LDB(B1, 0, 1); PG8_SCHED; PG8_LDA(At, 0, 0); PG8_STAGE(PG8_SA(1, 1), a1 + hstepA, voffA);
            PG8_WAIT_V(8); PG8_WAIT_L(0); PG8_BAR; PG8_MMA(0, 0, At, B0); PG8_MMA(0, 1, At, B1); PG8_BAR; PG8_SCHED;
            PG8_LDA(At, 0, 1); PG8_STAGE(PG8_SB(0, 0), b2, voffB); PG8_STAGE(PG8_SB(0, 1), b2 + hstepB, voffB); PG8_STAGE(PG8_SA(0, 0), a2, voffA);
            PG8_WAIT_V(8); PG8_WAIT_L(0); PG8_BAR; PG8_MMA(1, 0, At, B0); PG8_MMA(1, 1, At, B1); PG8_BAR; PG8_SCHED;
            PG8_LDB(B0, 1, 0); PG8_LDB(B1, 1, 1); PG8_SCHED; PG8_LDA(At, 1, 0); PG8_STAGE(PG8_SA(0, 1), a2 + hstepA, voffA);
            PG8_WAIT_V(8); PG8_WAIT_L(0); PG8_BAR; PG8_MMA(0, 0, At, B0); PG8_MMA(0, 1, At, B1); PG8_BAR; PG8_SCHED;
            PG8_LDA(At, 1, 1); PG8_STAGE(PG8_SB(1, 0), b3, voffB); PG8_STAGE(PG8_SB(1, 1), b3 + hstepB, voffB); PG8_STAGE(PG8_SA(1, 0), a3, voffA);
            PG8_WAIT_V(8); PG8_WAIT_L(0); PG8_BAR; PG8_MMA(1, 0, At, B0); PG8_MMA(1, 1, At, B1); PG8_BAR; PG8_SCHED;
        }
        if (wr == 0) PG8_BAR;
        const bool keep = E(acc, cur, wr, wc, fr, fq);
        if (!has_next) break;
        if (!keep) {
#pragma unroll
        for (int a = 0; a < 2; ++a)
#pragma unroll
            for (int b = 0; b < 2; ++b)
#pragma unroll
                for (int m = 0; m < 4; ++m)
#pragma unroll
                    for (int n = 0; n < 2; ++n) acc[a][b][m][n] = (f32x4){0.f, 0.f, 0.f, 0.f};
        }
        cur = nxt; cA = nA; cB = nB; ++ui;
        if (wr == 1) PG8_BAR;
    }
    PG8_WAIT_V(0);
    PG8_BAR;
#undef PG8_SA
#undef PG8_SB
#undef PG8_STAGE
#undef PG8_LDA
#undef PG8_LDB
#undef PG8_MMA
#undef PG8_WAIT_V
#undef PG8_WAIT_L
#undef PG8_BAR
#undef PG8_SCHED
}
}

#define XB_TMO      128
#define XB_XCNT(j)  (256  + 64 * (j))
#define XB_XSUB(j)  (1280 + 64 * (j))
#define XB_XGEN(j)  (2304 + 64 * (j))
#define XB_TOP      3328
#define XB_TOPGEN   3392
#define XCD_BAR_WORDS 3456
#define XB_SPIN_CAP (1u << 18)
__device__ __forceinline__ unsigned xb_ld(unsigned* p)              { return __hip_atomic_load(p, __ATOMIC_RELAXED, __HIP_MEMORY_SCOPE_AGENT); }
__device__ __forceinline__ unsigned xb_add(unsigned* p, unsigned v) { asm volatile("" : "+v"(v)); return __hip_atomic_fetch_add(p, v, __ATOMIC_RELAXED, __HIP_MEMORY_SCOPE_AGENT); }
__device__ __forceinline__ unsigned xb_xcc_id() { return (unsigned)__builtin_amdgcn_s_getreg((3 << 11) | 20) & 0xFu; }
#define XB_SPIN(cond, bar) do { unsigned _sp = 0; while (cond) { __builtin_amdgcn_s_sleep(1); \
    if ((++_sp & 255u) == 0u) { if (xb_ld(&(bar)[XB_TMO])) break; if (_sp > XB_SPIN_CAP) { (void)xb_add(&(bar)[XB_TMO], 1u); break; } } } } while (0)
struct XcdBarrier { unsigned* bar; unsigned x; volatile LAS unsigned* st; };
__device__ __forceinline__ XcdBarrier xcd_barrier_post(unsigned* bar, volatile LAS unsigned* st) {
    XcdBarrier b; b.bar = bar; b.x = xb_xcc_id(); b.st = st;
    if (threadIdx.x == 0) (void)xb_add(&bar[XB_XCNT(b.x)], 1u);
    return b;
}
__device__ __forceinline__ void xcd_barrier_complete(unsigned* bar, unsigned x, unsigned& nloc, unsigned& nx) {
    const unsigned G = gridDim.x * gridDim.y * gridDim.z;
    unsigned sum, cnt, mine, sp = 0u;
    for (;;) {
        sum = 0u; cnt = 0u; mine = 0u;
#pragma unroll 1
        for (unsigned j = 0; j < 16; ++j) { const unsigned c = xb_ld(&bar[XB_XCNT(j)]); sum += c; cnt += (c > 0u) ? 1u : 0u; mine = (j == x) ? c : mine; }
        if (sum == G) break;
        __builtin_amdgcn_s_sleep(1);
        if ((++sp & 255u) == 0u) { if (xb_ld(&bar[XB_TMO])) break; if (sp > XB_SPIN_CAP) { (void)xb_add(&bar[XB_TMO], 1u); break; } }
    }
    nloc = mine > 0u ? mine : 1u; nx = cnt > 0u ? cnt : 1u;
}
__device__ __forceinline__ void xcd_barrier(const XcdBarrier& b) {
    asm volatile("s_waitcnt vmcnt(0)" ::: "memory");
    __syncthreads();
    if (threadIdx.x == 0) {
        unsigned* bar = b.bar; asm volatile("" : "+s"(bar));
        __builtin_amdgcn_s_waitcnt(0);
        unsigned nloc = b.st[0], nx = b.st[1];
        if (nloc == 0u) { xcd_barrier_complete(bar, b.x, nloc, nx); b.st[0] = nloc; b.st[1] = nx; }
        const unsigned old = xb_add(&bar[XB_XSUB(b.x)], 1u);
        const unsigned gen = old / nloc;
        if (old + 1u == (gen + 1u) * nloc) {
            __builtin_amdgcn_fence(__ATOMIC_RELEASE, "agent");
            asm volatile("s_waitcnt vmcnt(0)" ::: "memory");
            const unsigned og = xb_add(&bar[XB_TOP], 1u);
            const unsigned tg = og / nx;
            if (og + 1u == (tg + 1u) * nx) xb_add(&bar[XB_TOPGEN], 1u);
            else XB_SPIN(xb_ld(&bar[XB_TOPGEN]) == tg, bar);
            __builtin_amdgcn_fence(__ATOMIC_ACQUIRE, "agent");
            xb_add(&bar[XB_XGEN(b.x)], 1u);
            asm volatile("s_waitcnt vmcnt(0)" ::: "memory");
        } else {
            XB_SPIN(xb_ld(&bar[XB_XGEN(b.x)]) == gen, bar);
            __builtin_amdgcn_fence(__ATOMIC_ACQUIRE, "agent");
            asm volatile("s_waitcnt vmcnt(0)" ::: "memory");
        }
    }
    __syncthreads();
}

constexpr int BATCH = 4, SEQ = 4096, T = BATCH * SEQ, D = 1024, DEPTH = 2;
constexpr int NPROJ = 6656;
constexpr int NP = 6784;
constexpr int VTP = T + 128;
constexpr int C_QA = 0, C_KA = 512, C_QB = 1024, C_KB = 1536, C_QC = 2048, C_KC = 2560, C_GATE = 3072, C_QI = 6144, C_KI = 6400, C_WI = 6464;
constexpr int DFF = 2816, DFFE = 3584, NE = 8;
constexpr int XP_ROWS = 2 * T + 2048;
constexpr float LOG2E = 1.4426950408889634f;
constexpr float C2 = 0.125f * LOG2E;
constexpr int NWAVES = 8, NTHREADS = 512;

constexpr size_t MiB = 1u << 20;
constexpr size_t WS_CTL = 0, CTL_ZERO_BYTES = 64 * 1024;
constexpr size_t WS_MOD = 1 * MiB;
constexpr size_t WS_RTE = 1 * MiB + 256 * 1024;
constexpr size_t WS_RTW = WS_RTE + 64 * 1024;
constexpr size_t WS_POS = WS_RTW + 128 * 1024;
constexpr size_t WS_WGCNT = WS_POS + 128 * 1024;
constexpr size_t WS_TILETAB = WS_WGCNT + 8 * 1024;
constexpr size_t WS_XBUF = 2 * MiB;
constexpr size_t WS_MW13 = 3 * MiB, WS_MW2 = 115 * MiB;
constexpr size_t WS_WIN = 171 * MiB, WS_WV = WS_WIN + 26 * MiB, WS_WBR = WS_WV + 6 * MiB, WS_WOUT = WS_WBR + 6 * MiB, WS_W13 = WS_WOUT + 4 * MiB, WS_W2 = WS_W13 + 11 * MiB;
constexpr size_t WS_OC = WS_W2 + 6 * MiB;
constexpr size_t WS_MASK = WS_OC + 16 * MiB;
constexpr size_t WS_WI = WS_MASK + 8 * MiB;
constexpr size_t WS_XP = WS_WIN;
constexpr size_t WS_XN = 256 * MiB;
constexpr size_t WS_OA = WS_XN, WS_OB = WS_XN + 16 * MiB;
constexpr size_t WS_PROJ = 288 * MiB;
constexpr size_t WS_VT = WS_PROJ + 212 * MiB;
constexpr size_t WS_MERGED = WS_VT;
constexpr size_t WS_HID = WS_PROJ;
constexpr size_t WS_END = WS_VT + 49 * MiB;
static_assert(WS_WI + 256 * 1024 <= WS_XN && WS_XP + (size_t)XP_ROWS * 2048 <= WS_XN, "ws map");
static_assert(WS_HID + (size_t)XP_ROWS * DFFE * 2 <= WS_END && WS_PROJ + (size_t)T * NP * 2 <= WS_VT && WS_VT + (size_t)1536 * VTP * 2 <= WS_END, "ws map hid");
constexpr int CW_TMO = 0, CW_BAR = 1024, CW_PANEL = 8192;
constexpr int CW_DUMMY_ = 0;

struct Seg { int in_idx; long long src_off; int ldw, K, ncols; unsigned long long dst; int row0, blk, stride, item0; };
constexpr int NSEG = 61, SEG_ITEMS = 28928;
__device__ const Seg g_segs[NSEG] = {
{6, 0, 8004, 1024, 512, 179306496ull, 0, 1073741824, 0, 0},
{6, 512, 8004, 1024, 512, 179306496ull, 512, 1073741824, 0, 128},
{6, 1024, 8004, 1024, 512, 206569472ull, 0, 1073741824, 0, 256},
{6, 1536, 8004, 1024, 256, 179306496ull, 6144, 1073741824, 0, 384},
{6, 1792, 8004, 1024, 64, 179306496ull, 6400, 1073741824, 0, 448},
{6, 1856, 8004, 1024, 4, 179306496ull, 6464, 1073741824, 0, 464},
{6, 1860, 8004, 1024, 512, 179306496ull, 1024, 1073741824, 0, 480},
{6, 2372, 8004, 1024, 512, 179306496ull, 1536, 1073741824, 0, 608},
{6, 2884, 8004, 1024, 512, 206569472ull, 512, 1073741824, 0, 736},
{6, 3396, 8004, 1024, 512, 179306496ull, 2048, 1073741824, 0, 864},
{6, 3908, 8004, 1024, 512, 179306496ull, 2560, 1073741824, 0, 992},
{6, 4420, 8004, 1024, 512, 206569472ull, 1024, 1073741824, 0, 1120},
{6, 4932, 8004, 1024, 3072, 179306496ull, 3072, 1073741824, 0, 1248},
{7, 0, 1024, 512, 1024, 212860928ull, 0, 1073741824, 0, 2016},
{7, 524288, 1024, 512, 1024, 213909504ull, 0, 1073741824, 0, 2144},
{7, 1048576, 1024, 512, 1024, 214958080ull, 0, 1073741824, 0, 2272},
{8, 0, 1024, 1024, 1024, 219152384ull, 0, 1073741824, 0, 2400},
{6, 8196096, 8004, 1024, 512, 192937984ull, 0, 1073741824, 0, 2656},
{6, 8196608, 8004, 1024, 512, 192937984ull, 512, 1073741824, 0, 2784},
{6, 8197120, 8004, 1024, 512, 209715200ull, 0, 1073741824, 0, 2912},
{6, 8197632, 8004, 1024, 256, 192937984ull, 6144, 1073741824, 0, 3040},
{6, 8197888, 8004, 1024, 64, 192937984ull, 6400, 1073741824, 0, 3104},
{6, 8197952, 8004, 1024, 4, 192937984ull, 6464, 1073741824, 0, 3120},
{6, 8197956, 8004, 1024, 512, 192937984ull, 1024, 1073741824, 0, 3136},
{6, 8198468, 8004, 1024, 512, 192937984ull, 1536, 1073741824, 0, 3264},
{6, 8198980, 8004, 1024, 512, 209715200ull, 512, 1073741824, 0, 3392},
{6, 8199492, 8004, 1024, 512, 192937984ull, 2048, 1073741824, 0, 3520},
{6, 8200004, 8004, 1024, 512, 192937984ull, 2560, 1073741824, 0, 3648},
{6, 8200516, 8004, 1024, 512, 209715200ull, 1024, 1073741824, 0, 3776},
{6, 8201028, 8004, 1024, 3072, 192937984ull, 3072, 1073741824, 0, 3904},
{7, 1572864, 1024, 512, 1024, 216006656ull, 0, 1073741824, 0, 4672},
{7, 2097152, 1024, 512, 1024, 217055232ull, 0, 1073741824, 0, 4800},
{7, 2621440, 1024, 512, 1024, 218103808ull, 0, 1073741824, 0, 4928},
{8, 1048576, 1024, 1024, 1024, 221249536ull, 0, 1073741824, 0, 5056},
{12, 0, 2816, 1024, 2816, 223346688ull, 0, 32, 64, 5312},
{13, 0, 2816, 1024, 2816, 223346688ull, 32, 32, 64, 6016},
{14, 0, 1024, 2816, 1024, 234881024ull, 0, 1073741824, 0, 6720},
{17, 0, 3584, 1024, 3584, 3145728ull, 0, 32, 64, 7424},
{18, 0, 3584, 1024, 3584, 3145728ull, 32, 32, 64, 8320},
{19, 0, 1024, 3584, 1024, 120586240ull, 0, 1073741824, 0, 9216},
{17, 3670016, 3584, 1024, 3584, 17825792ull, 0, 32, 64, 10112},
{18, 3670016, 3584, 1024, 3584, 17825792ull, 32, 32, 64, 11008},
{19, 3670016, 1024, 3584, 1024, 127926272ull, 0, 1073741824, 0, 11904},
{17, 7340032, 3584, 1024, 3584, 32505856ull, 0, 32, 64, 12800},
{18, 7340032, 3584, 1024, 3584, 32505856ull, 32, 32, 64, 13696},
{19, 7340032, 1024, 3584, 1024, 135266304ull, 0, 1073741824, 0, 14592},
{17, 11010048, 3584, 1024, 3584, 47185920ull, 0, 32, 64, 15488},
{18, 11010048, 3584, 1024, 3584, 47185920ull, 32, 32, 64, 16384},
{19, 11010048, 1024, 3584, 1024, 142606336ull, 0, 1073741824, 0, 17280},
{17, 14680064, 3584, 1024, 3584, 61865984ull, 0, 32, 64, 18176},
{18, 14680064, 3584, 1024, 3584, 61865984ull, 32, 32, 64, 19072},
{19, 14680064, 1024, 3584, 1024, 149946368ull, 0, 1073741824, 0, 19968},
{17, 18350080, 3584, 1024, 3584, 76546048ull, 0, 32, 64, 20864},
{18, 18350080, 3584, 1024, 3584, 76546048ull, 32, 32, 64, 21760},
{19, 18350080, 1024, 3584, 1024, 157286400ull, 0, 1073741824, 0, 22656},
{17, 22020096, 3584, 1024, 3584, 91226112ull, 0, 32, 64, 23552},
{18, 22020096, 3584, 1024, 3584, 91226112ull, 32, 32, 64, 24448},
{19, 22020096, 1024, 3584, 1024, 164626432ull, 0, 1073741824, 0, 25344},
{17, 25690112, 3584, 1024, 3584, 105906176ull, 0, 32, 64, 26240},
{18, 25690112, 3584, 1024, 3584, 105906176ull, 32, 32, 64, 27136},
{19, 25690112, 1024, 3584, 1024, 171966464ull, 0, 1073741824, 0, 28032}
};

struct Args { const float* in[21]; float* out; unsigned char* ws; int ph_lo, ph_hi; };
__device__ __forceinline__ const float* karg_in(int i) {
    const __attribute__((address_space(4))) unsigned long long* p = (const __attribute__((address_space(4))) unsigned long long*)__builtin_amdgcn_kernarg_segment_ptr();
    int j = i; asm volatile("" : "+s"(j));
    return (const float*)p[j];
}
__device__ __forceinline__ int karg_int(int word) {
    const __attribute__((address_space(4))) int* p = (const __attribute__((address_space(4))) int*)__builtin_amdgcn_kernarg_segment_ptr();
    int j = word; asm volatile("" : "+s"(j));
    return p[j];
}
__device__ __forceinline__ unsigned char* wsp(unsigned char* ws, unsigned long long off) { asm volatile("" : "+s"(off)); return ws + off; }


struct TileSched {
    unsigned A, B, astep, bstep; int nM, nN, nwg, G, c, ord;
    __device__ void init(size_t A_, size_t B_, int M, int N, int lda, int ldb, int G_, int c_) {
        A = (unsigned)A_; B = (unsigned)B_; astep = 256u * lda * 2; bstep = 256u * ldb * 2; nM = M / 256; nN = N / 256; nwg = nM * nN; G = G_; c = c_; ord = 0; }
    __device__ bool next(int i, pg8::Unit& u) const {
        const int L = i * G + c; if (L >= nwg) return false;
#ifndef XCD_ORDER
        if (ord == 2 || (ord == 0 && nM == 64)) {
             u.pm = L / nN; u.pn = L - u.pm * nN; u.aux = 0; u.a = A + (unsigned)u.pm * astep; u.b = B + (unsigned)u.pn * bstep; return true; }
#endif
        int wgid = L; { const int q = nwg / pg8::NXCD, r = nwg % pg8::NXCD, xcd = wgid % pg8::NXCD, off = wgid / pg8::NXCD; wgid = (xcd < r ? xcd * (q + 1) : r * (q + 1) + (xcd - r) * q) + off; }
        const int nig = pg8::WGM * nN, gid = wgid / nig, fm = gid * pg8::WGM, gsz = (nM - fm) < pg8::WGM ? (nM - fm) : pg8::WGM;
        u.pm = fm + ((wgid % nig) % gsz); u.pn = (wgid % nig) / gsz; u.aux = 0; u.a = A + (unsigned)u.pm * astep; u.b = B + (unsigned)u.pn * bstep; return true;
    }
};
struct BranchSched {
    unsigned B; int c;
    __device__ bool next(int i, pg8::Unit& u) const {
        if (i >= 3 || c >= 256) return false;
        u.pm = c >> 2; u.pn = c & 3; u.aux = i;
        const unsigned Ab = (i == 0) ? (unsigned)WS_OA : (i == 1 ? (unsigned)WS_OB : (unsigned)WS_OC);
        u.a = Ab + (unsigned)u.pm * (256u * 512 * 2); u.b = B + (unsigned)i * (unsigned)MiB + (unsigned)u.pn * (256u * 512 * 2); return true;
    }
};
struct MoeSched {
    unsigned A, B; const int* tab; unsigned astep, bstep, estep; int nN, G, c; int ks; unsigned kbytes, kbytesA;
    __device__ bool next(int i, pg8::Unit& u) const {
        const int nt = tab[0];
#ifdef MOE_XCD
        if (ks == 1 && G == 256 && nN == 16) {
            const int x = c & 7, j = c >> 3;
            u.pm = i * 16 + (x >> 2) * 8 + (j >> 2); u.pn = (x & 3) * 4 + (j & 3); u.aux = 0;
            if (u.pm >= nt) return false;
            const int e = tab[1 + u.pm];
            u.a = A + (unsigned)u.pm * astep; u.b = B + (unsigned)e * estep + (unsigned)u.pn * bstep; return true;
        }
#endif
#if defined(MOE_XCD) && MOE_XCD == 2
        if (ks == 1 && G == 256) {
            const int tot = nt * nN, q = (tot + 7) >> 3, x = c & 7, j = c >> 3, li = i * 32 + j;
            if (li >= q) return false;
            const int idx = x * q + li; if (idx >= tot) return false;
            const int nig = 8 * nN, gid = idx / nig, fm = gid * 8, gsz = (nt - fm) < 8 ? (nt - fm) : 8, w = idx - gid * nig;
            u.pn = w / gsz; u.pm = fm + (w - u.pn * gsz); u.aux = 0;
            const int e = tab[1 + u.pm];
            u.a = A + (unsigned)u.pm * astep; u.b = B + (unsigned)e * estep + (unsigned)u.pn * bstep; return true;
        }
#endif
        const int L = i * G + c; if (L >= nt * nN * ks) return false;
        const int L2 = L / ks; u.aux = L - L2 * ks;
        u.pm = L2 / nN; u.pn = L2 - u.pm * nN;
        const int e = tab[1 + u.pm];
        u.a = A + (unsigned)u.pm * astep + (unsigned)u.aux * kbytesA; u.b = B + (unsigned)e * estep + (unsigned)u.pn * bstep + (unsigned)u.aux * kbytes; return true;
    }
};

template <class Sched>
__device__ __forceinline__ void fill_units(LAS unsigned char* lds, const Sched& S) {
    LAS u32x4* ut = (LAS u32x4*)(lds + pg8::UT_OFF);
    const int tid = otid();
    if (tid < 64) { pg8::Unit u; u.nt = 0; u32x4 e = {0u, 0u, 0u, 0u};
        if (S.next(tid, u)) { e.x = u.a; e.y = u.b; e.z = (unsigned)u.pm | ((unsigned)u.pn << 12) | ((unsigned)u.aux << 24); e.w = 0x10000u | (unsigned)u.nt; }
        ut[tid] = e; }
    __syncthreads();
}

#ifdef EPI_NT
#define EPI_ST16(p, v) __builtin_nontemporal_store((v), (p))
#else
#define EPI_ST16(p, v) (*(p) = (v))
constexpr int EPI_SCR_OFF = 133120, EPI_SCR_WAVE = 2304;
__device__ __forceinline__ void epi_store_16x64(LAS unsigned char* scr, bf16_t* tile  , size_t pitch, int fr, int fq, const u32x4& w0, const u32x4& w1) {
    *(LAS u32x4*)(scr + fr * 144 + fq * 16) = w0; *(LAS u32x4*)(scr + fr * 144 + 64 + fq * 16) = w1;
    const int lane = fr + 16 * fq, r8 = lane >> 3, ch = lane & 7;
    const u32x4 a = *(const LAS u32x4*)(scr + r8 * 144 + ch * 16), b = *(const LAS u32x4*)(scr + (r8 + 8) * 144 + ch * 16);
#ifdef EPI_WT
    asm volatile("global_store_dwordx4 %0, %1, off sc1\n\ts_nop 1" :: "v"(tile + (size_t)r8 * pitch + ch * 8), "v"(a) : "memory");
    asm volatile("global_store_dwordx4 %0, %1, off sc1\n\ts_nop 1" :: "v"(tile + (size_t)(r8 + 8) * pitch + ch * 8), "v"(b) : "memory");
#else
    *(GAS u32x4*)(tile + (size_t)r8 * pitch + ch * 8) = a; *(GAS u32x4*)(tile + (size_t)(r8 + 8) * pitch + ch * 8) = b;
#endif
}
#endif
__device__ __forceinline__ float sigmoidf_(float v) { return frcp(1.f + fexp2(-v * LOG2E)); }
struct EpiProj {
    static constexpr bool PERM = true;
    bf16_t* O; float* WI; LAS unsigned char* lds;
    __device__ __forceinline__ bool operator()(const f32x4 (&acc)[2][2][4][2], const pg8::Unit& u, int wr, int wc, int fr, int fq) const {
        const int pn = u.pn; const bool gate = (pn >= 12 && pn < 24);
        const float sc = (pn < 2 || pn == 4 || pn == 5 || pn == 8 || pn == 9) ? C2 : (pn == 24 ? 0.125f : 1.f);
        const int row0 = u.pm * 256 + wr * 64 + fr;
        LAS unsigned char* scr = lds + EPI_SCR_OFF + (wr * 4 + wc) * EPI_SCR_WAVE;
#pragma unroll
        for (int ai = 0; ai < 2; ++ai)
#pragma unroll
            for (int m = 0; m < 4; ++m) { u32x4 w[2];
#pragma unroll
                for (int bj = 0; bj < 2; ++bj) { f32x4 v0 = acc[ai][bj][m][0], v1 = acc[ai][bj][m][1];
                    if (gate) {
#pragma unroll
                        for (int k = 0; k < 4; ++k) { v0[k] = sigmoidf_(v0[k]); v1[k] = sigmoidf_(v1[k]); }
                    } else { v0 = v0 * sc; v1 = v1 * sc; }
                    w[bj].x = cvtpk(v0[0], v0[1]); w[bj].y = cvtpk(v0[2], v0[3]); w[bj].z = cvtpk(v1[0], v1[1]); w[bj].w = cvtpk(v1[2], v1[3]); }
                epi_store_16x64(scr, O + (size_t)(u.pm * 256 + wr * 64 + ai * 128 + m * 16) * NP + pn * 256 + wc * 64, NP, fr, fq, w[0], w[1]); }
        if (pn == 25 && wc == 1 && fq == 0) {
#pragma unroll
            for (int ai = 0; ai < 2; ++ai)
#pragma unroll
                for (int m = 0; m < 4; ++m) *(GAS f32x4*)(WI + (size_t)(row0 + ai * 128 + m * 16) * 4) = acc[ai][0][m][0] * 0.5f;
        }
        return false;
    }
};
struct EpiNone {
    static constexpr bool PERM = true;
    bf16_t* O;
    __device__ __forceinline__ bool operator()(const f32x4 (&acc)[2][2][4][2], const pg8::Unit& u, int wr, int wc, int fr, int fq) const {
        float s = 0.f;
#pragma unroll
        for (int ai = 0; ai < 2; ++ai)
#pragma unroll
            for (int bj = 0; bj < 2; ++bj)
#pragma unroll
                for (int m = 0; m < 4; ++m)
#pragma unroll
                    for (int n = 0; n < 2; ++n) s += acc[ai][bj][m][n][0] + acc[ai][bj][m][n][1] + acc[ai][bj][m][n][2] + acc[ai][bj][m][n][3];
        if (s == 1.2345e30f) O[0] = 1;
        return false;
    }
};
struct EpiQuarter {
    static constexpr bool PERM = true;
    bf16_t* O; int ldc;
    __device__ __forceinline__ bool operator()(const f32x4 (&acc)[2][2][4][2], const pg8::Unit& u, int wr, int wc, int fr, int fq) const {
        const int row0 = u.pm * 256 + wr * 64 + fr, col0 = u.pn * 256 + wc * 64 + 8 * fq;
        float s = 0.f;
#pragma unroll
        for (int ai = 0; ai < 2; ++ai)
#pragma unroll
            for (int m = 0; m < 4; ++m) { bf16_t* rowp = O + (size_t)(row0 + ai * 128 + m * 16) * ldc + col0;
#pragma unroll
                for (int bj = 0; bj < 2; ++bj) { const f32x4 v0 = acc[ai][bj][m][0], v1 = acc[ai][bj][m][1];
                    u32x4 w; w.x = cvtpk(v0[0], v0[1]); w.y = cvtpk(v0[2], v0[3]); w.z = cvtpk(v1[0], v1[1]); w.w = cvtpk(v1[2], v1[3]);
                    if (m == 0 && ai == 0) EPI_ST16((GAS u32x4*)(rowp + bj * 32), w); else s += __uint_as_float(w.x ^ w.y ^ w.z ^ w.w); } }
        if (s == 1.2345e30f) O[0] = 1;
        return false;
    }
};
struct EpiBlocked {
    static constexpr bool PERM = true;
    bf16_t* O;
    __device__ __forceinline__ bool operator()(const f32x4 (&acc)[2][2][4][2], const pg8::Unit& u, int wr, int wc, int fr, int fq) const {
        const int row0 = u.pm * 256 + wr * 64 + fr, col0 = wc * 64 + 8 * fq;
#pragma unroll
        for (int ai = 0; ai < 2; ++ai)
#pragma unroll
            for (int m = 0; m < 4; ++m) { bf16_t* rowp = O + (size_t)u.pn * ((size_t)T * 256) + (size_t)(row0 + ai * 128 + m * 16) * 256 + col0;
#pragma unroll
                for (int bj = 0; bj < 2; ++bj) { const f32x4 v0 = acc[ai][bj][m][0], v1 = acc[ai][bj][m][1];
                    u32x4 w; w.x = cvtpk(v0[0], v0[1]); w.y = cvtpk(v0[2], v0[3]); w.z = cvtpk(v1[0], v1[1]); w.w = cvtpk(v1[2], v1[3]);
                    *(GAS u32x4*)(rowp + bj * 32) = w; } }
        return false;
    }
};
struct EpiLinear {
    static constexpr bool PERM = true;
    bf16_t* O;
    __device__ __forceinline__ bool operator()(const f32x4 (&acc)[2][2][4][2], const pg8::Unit& u, int wr, int wc, int fr, int fq) const {
        const int lane = fr + 16 * fq, wv = wr * 4 + wc;
        bf16_t* base = O + ((size_t)(u.pm * 26 + u.pn) * 65536) + (size_t)wv * 8192 + lane * 8;
#pragma unroll
        for (int ai = 0; ai < 2; ++ai)
#pragma unroll
            for (int m = 0; m < 4; ++m)
#pragma unroll
                for (int bj = 0; bj < 2; ++bj) { const f32x4 v0 = acc[ai][bj][m][0], v1 = acc[ai][bj][m][1];
                    u32x4 w; w.x = cvtpk(v0[0], v0[1]); w.y = cvtpk(v0[2], v0[3]); w.z = cvtpk(v1[0], v1[1]); w.w = cvtpk(v1[2], v1[3]);
                    *(GAS u32x4*)(base + ((ai * 4 + m) * 2 + bj) * 512) = w; }
        return false;
    }
};
struct EpiBf16 {
    static constexpr bool PERM = true;
    bf16_t* O; int ldc; LAS unsigned char* lds;
    __device__ __forceinline__ bool operator()(const f32x4 (&acc)[2][2][4][2], const pg8::Unit& u, int wr, int wc, int fr, int fq) const {
        LAS unsigned char* scr = lds + EPI_SCR_OFF + (wr * 4 + wc) * EPI_SCR_WAVE;
#pragma unroll
        for (int ai = 0; ai < 2; ++ai)
#pragma unroll
            for (int m = 0; m < 4; ++m) { u32x4 w[2];
#pragma unroll
                for (int bj = 0; bj < 2; ++bj) { const f32x4 v0 = acc[ai][bj][m][0], v1 = acc[ai][bj][m][1];
                    w[bj].x = cvtpk(v0[0], v0[1]); w[bj].y = cvtpk(v0[2], v0[3]); w[bj].z = cvtpk(v1[0], v1[1]); w[bj].w = cvtpk(v1[2], v1[3]); }
                epi_store_16x64(scr, O + (size_t)(u.pm * 256 + wr * 64 + ai * 128 + m * 16) * ldc + u.pn * 256 + wc * 64, (size_t)ldc, fr, fq, w[0], w[1]); }
        return false;
    }
};
struct EpiBf16Split {
    static constexpr bool PERM = true;
    bf16_t* O0; bf16_t* O1; int ldc; LAS unsigned char* lds;
    __device__ __forceinline__ bool operator()(const f32x4 (&acc)[2][2][4][2], const pg8::Unit& u, int wr, int wc, int fr, int fq) const {
        bf16_t* O = u.aux ? O1 : O0;
        LAS unsigned char* scr = lds + EPI_SCR_OFF + (wr * 4 + wc) * EPI_SCR_WAVE;
#pragma unroll
        for (int ai = 0; ai < 2; ++ai)
#pragma unroll
            for (int m = 0; m < 4; ++m) { u32x4 w[2];
#pragma unroll
                for (int bj = 0; bj < 2; ++bj) { const f32x4 v0 = acc[ai][bj][m][0], v1 = acc[ai][bj][m][1];
                    w[bj].x = cvtpk(v0[0], v0[1]); w[bj].y = cvtpk(v0[2], v0[3]); w[bj].z = cvtpk(v1[0], v1[1]); w[bj].w = cvtpk(v1[2], v1[3]); }
                epi_store_16x64(scr, O + (size_t)(u.pm * 256 + wr * 64 + ai * 128 + m * 16) * ldc + u.pn * 256 + wc * 64, (size_t)ldc, fr, fq, w[0], w[1]); }
        return false;
    }
};
struct EpiBranch {
    static constexpr bool PERM = true;
    const bf16_t* G; bf16_t* O; LAS unsigned char* lds;
    static __device__ __forceinline__ float rat(float a, float b) { return a * frcp(fmaxf(b, 1e-30f)); }
    __device__ __forceinline__ bool operator()(f32x4 (&acc)[2][2][4][2], const pg8::Unit& u, int wr, int wc, int fr, int fq) const {
        const int sub = u.aux;
        const int row0 = u.pm * 256 + wr * 64 + fr, col0 = u.pn * 256 + wc * 64 + 8 * fq;
        LAS unsigned char* scr = lds + EPI_SCR_OFF + (wr * 4 + wc) * EPI_SCR_WAVE;
#pragma unroll
        for (int ai = 0; ai < 2; ++ai)
#pragma unroll
            for (int m = 0; m < 4; ++m) { const unsigned r = (unsigned)(row0 + ai * 128 + m * 16); u32x4 w[2];
#pragma unroll
                for (int bj = 0; bj < 2; ++bj) {
                    const bf16_t* gp = G + (size_t)r * NP + col0 + bj * 32;
                    const u32x4 gx = *(const GAS u32x4*)(gp + sub * 1024);
                    f32x4 f0 = {bf_lo(gx.x), bf_hi(gx.x), bf_lo(gx.y), bf_hi(gx.y)}, f1 = {bf_lo(gx.z), bf_hi(gx.z), bf_lo(gx.w), bf_hi(gx.w)};
                    if (sub < 2) { const u32x4 gy = *(const GAS u32x4*)(gp + (sub + 1) * 1024);
                        f0 = (f32x4){rat(f0.x, bf_lo(gy.x)), rat(f0.y, bf_hi(gy.x)), rat(f0.z, bf_lo(gy.y)), rat(f0.w, bf_hi(gy.y))};
                        f1 = (f32x4){rat(f1.x, bf_lo(gy.z)), rat(f1.y, bf_hi(gy.z)), rat(f1.z, bf_lo(gy.w)), rat(f1.w, bf_hi(gy.w))}; }
                    const f32x4 v0 = acc[ai][bj][m][0] * f0, v1 = acc[ai][bj][m][1] * f1;
                    acc[ai][bj][m][0] = v0; acc[ai][bj][m][1] = v1;
                    w[bj].x = cvtpk(v0[0], v0[1]); w[bj].y = cvtpk(v0[2], v0[3]); w[bj].z = cvtpk(v1[0], v1[1]); w[bj].w = cvtpk(v1[2], v1[3]); }
                if (sub == 2) epi_store_16x64(scr, O + (size_t)(u.pm * 256 + wr * 64 + ai * 128 + m * 16) * 1024 + u.pn * 256 + wc * 64, 1024, fr, fq, w[0], w[1]); }
        return sub < 2;
    }
};
struct EpiResid {
    static constexpr bool PERM = false;
    const float* xin; float* xout; const float* gate; LAS unsigned char* lds;
    __device__ __forceinline__ bool operator()(const f32x4 (&acc)[2][2][4][2], const pg8::Unit& u, int wr, int wc, int fr, int fq) const {
        const int row0 = u.pm * 256 + wr * 64 + fr, col0 = u.pn * 256 + wc * 64 + 4 * fq;
        const float* gp = gate + (size_t)(u.pm >> 4) * 6144 + col0;
        LAS unsigned char* scr = lds + EPI_SCR_OFF + (wr * 4 + wc) * EPI_SCR_WAVE;
        f32x4 gv[2][2];
#pragma unroll
        for (int bj = 0; bj < 2; ++bj)
#pragma unroll
            for (int n = 0; n < 2; ++n) gv[bj][n] = *(const GAS f32x4*)(gp + bj * 32 + n * 16);
#pragma unroll
        for (int am = 0; am < 8; am += 2) {
            f32x4 xv[2][2][2];
#pragma unroll
            for (int q = 0; q < 2; ++q) { const int ai = (am + q) >> 2, m = (am + q) & 3; const size_t off = (size_t)(row0 + ai * 128 + m * 16) * D + col0;
#pragma unroll
                for (int bj = 0; bj < 2; ++bj)
#pragma unroll
                    for (int n = 0; n < 2; ++n) xv[q][bj][n] = *(const GAS f32x4*)(xin + off + bj * 32 + n * 16); }
#pragma unroll
            for (int q = 0; q < 2; ++q) { const int ai = (am + q) >> 2, m = (am + q) & 3; const size_t off = (size_t)(row0 + ai * 128 + m * 16) * D + col0;
#pragma unroll
                for (int bj = 0; bj < 2; ++bj)
                    { const f32x4 r0 = xv[q][bj][0] + gv[bj][0] * acc[ai][bj][m][0], r1 = xv[q][bj][1] + gv[bj][1] * acc[ai][bj][m][1]; (void)off;
                      epi_store_16x64(scr, (bf16_t*)(xout + (size_t)(u.pm * 256 + wr * 64 + ai * 128 + m * 16) * D + u.pn * 256 + wc * 64 + bj * 32), 2 * (size_t)D, fr, fq, __builtin_bit_cast(u32x4, r0), __builtin_bit_cast(u32x4, r1)); } }
        }
        return false;
    }
};
constexpr int EPN_P_OFF = 151552, EPN_S_OFF = EPN_P_OFF + 4096, EPN_F_OFF = EPN_S_OFF + 1024;
struct EpiResidNorm {
    static constexpr bool PERM = false;
    const float* xin; float* xout; const float* gate; LAS unsigned char* lds;
    const float* ng; unsigned char* ws; int shoff, scoff, cntw;
    __device__ __forceinline__ bool operator()(f32x4 (&acc)[2][2][4][2], const pg8::Unit& u, int wr, int wc, int fr, int fq) const {
        const int row0 = u.pm * 256 + wr * 64 + fr, col0 = u.pn * 256 + wc * 64 + 4 * fq, wv = wr * 4 + wc, lane = fr + 16 * fq;
        const float* gp = gate + (size_t)(u.pm >> 4) * 6144 + col0;
        LAS unsigned char* scr = lds + EPI_SCR_OFF + wv * EPI_SCR_WAVE;
        LAS float* P = (LAS float*)(lds + EPN_P_OFF); LAS float* S = (LAS float*)(lds + EPN_S_OFF); volatile LAS unsigned* flag = (volatile LAS unsigned*)(lds + EPN_F_OFF);
        float* xbuf = (float*)wsp(ws, WS_XBUF); unsigned* cnt = (unsigned*)wsp(ws, WS_CTL) + cntw;
        {
            f32x4 gv[2][2];
#pragma unroll
            for (int bj = 0; bj < 2; ++bj)
#pragma unroll
                for (int n = 0; n < 2; ++n) gv[bj][n] = *(const GAS f32x4*)(gp + bj * 32 + n * 16);
#pragma unroll
            for (int ai = 0; ai < 2; ++ai)
#pragma unroll
                for (int m = 0; m < 4; ++m)
#pragma unroll
                    for (int bj = 0; bj < 2; ++bj)
#pragma unroll
                        for (int n = 0; n < 2; ++n) acc[ai][bj][m][n] = acc[ai][bj][m][n] * gv[bj][n];
            asm volatile("" ::: "memory");
#pragma unroll
            for (int am = 0; am < 8; am += 2) {
                f32x4 xv[2][2][2];
#pragma unroll
                for (int q = 0; q < 2; ++q) { const int ai = (am + q) >> 2, m = (am + q) & 3; const size_t off = (size_t)(row0 + ai * 128 + m * 16) * D + col0;
#pragma unroll
                    for (int bj = 0; bj < 2; ++bj)
#pragma unroll
                        for (int n = 0; n < 2; ++n) xv[q][bj][n] = *(const GAS f32x4*)(xin + off + bj * 32 + n * 16); }
#pragma unroll
                for (int q = 0; q < 2; ++q) { const int ai = (am + q) >> 2, m = (am + q) & 3;
#pragma unroll
                    for (int bj = 0; bj < 2; ++bj)
                        { const f32x4 r0 = xv[q][bj][0] + acc[ai][bj][m][0], r1 = xv[q][bj][1] + acc[ai][bj][m][1];
                          acc[ai][bj][m][0] = r0; acc[ai][bj][m][1] = r1;
                          epi_store_16x64(scr, (bf16_t*)(xout + (size_t)(u.pm * 256 + wr * 64 + ai * 128 + m * 16) * D + u.pn * 256 + wc * 64 + bj * 32), 2 * (size_t)D, fr, fq, __builtin_bit_cast(u32x4, r0), __builtin_bit_cast(u32x4, r1)); } }
            }
        }
        int fr1 = fr, fq1 = fq; asm volatile("" : "+v"(fr1), "+v"(fq1)); const int lane1 = fr1 + 16 * fq1;
#pragma unroll
        for (int ai = 0; ai < 2; ++ai)
#pragma unroll
            for (int m = 0; m < 4; ++m) { float s = 0.f;
#pragma unroll
                for (int bj = 0; bj < 2; ++bj)
#pragma unroll
                    for (int n = 0; n < 2; ++n) { const f32x4 x = acc[ai][bj][m][n]; s += (x[0] * x[0] + x[1] * x[1]) + (x[2] * x[2] + x[3] * x[3]); }
                s += __shfl_xor(s, 16); s += __shfl_xor(s, 32);
                if (fq1 == 0) P[(ai * 128 + wr * 64 + m * 16 + fr1) * 4 + wc] = s; }
        asm volatile("s_waitcnt lgkmcnt(0)" ::: "memory"); __builtin_amdgcn_s_barrier(); asm volatile("" ::: "memory");
        const int prow = wv * 32 + (lane1 & 31);
        if (lane1 < 32) { const f32x4 p = *(const LAS f32x4*)(P + prow * 4);
            __hip_atomic_store((unsigned*)xbuf + ((size_t)(u.pm * 256 + prow) * 4 + u.pn), __float_as_uint((p.x + p.y) + (p.z + p.w)), __ATOMIC_RELAXED, __HIP_MEMORY_SCOPE_AGENT); }
        asm volatile("s_waitcnt vmcnt(0)" ::: "memory");
        if (lane1 == 0) (void)__hip_atomic_fetch_add(cnt + 64 * u.pm, 1u, __ATOMIC_RELAXED, __HIP_MEMORY_SCOPE_AGENT);
        if (wv == 0) { unsigned sp = 0u;
            while ((unsigned)__builtin_amdgcn_readfirstlane((int)__hip_atomic_load(cnt + 64 * u.pm, __ATOMIC_RELAXED, __HIP_MEMORY_SCOPE_AGENT)) < 32u) { __builtin_amdgcn_s_sleep(1); if (++sp > (1u << 20)) break; }
            __builtin_amdgcn_fence(__ATOMIC_ACQUIRE, "agent");
            if (lane1 == 0) flag[0] = sp; }
        asm volatile("s_waitcnt vmcnt(0) lgkmcnt(0)" ::: "memory"); __builtin_amdgcn_s_barrier(); asm volatile("" ::: "memory");
        if (lane1 < 32) { const unsigned* sl = (const unsigned*)xbuf + (size_t)(u.pm * 256 + prow) * 4; float t = 0.f;
#pragma unroll
            for (int k = 0; k < 4; ++k) t += __uint_as_float(__hip_atomic_load(sl + k, __ATOMIC_RELAXED, __HIP_MEMORY_SCOPE_AGENT));
            S[prow] = 1.0f / sqrtf(t * (1.f / D) + 1e-6f); }
        asm volatile("s_waitcnt vmcnt(0) lgkmcnt(0)" ::: "memory"); __builtin_amdgcn_s_barrier(); asm volatile("" ::: "memory");
        int fr5 = fr, fq5 = fq; asm volatile("" : "+v"(fr5), "+v"(fq5)); const int lane5 = fr5 + 16 * fq5, col5 = u.pn * 256 + wc * 64 + 4 * fq5;
        f32x4 gn[2][2], sh[2][2];
#pragma unroll
        for (int bj = 0; bj < 2; ++bj)
#pragma unroll
            for (int n = 0; n < 2; ++n) { const int c = col5 + bj * 32 + n * 16; const float* mo = (const float*)wsp(ws, WS_MOD) + (size_t)(u.pm >> 4) * 6144 + c;
                gn[bj][n] = *(const GAS f32x4*)(ng + c) * (*(const GAS f32x4*)(mo + scoff) + 1.0f); sh[bj][n] = *(const GAS f32x4*)(mo + shoff); }
#pragma unroll
        for (int ai = 0; ai < 2; ++ai)
#pragma unroll
            for (int m = 0; m < 4; ++m) { const float rs = S[ai * 128 + wr * 64 + m * 16 + fr5];
#pragma unroll
                for (int bj = 0; bj < 2; ++bj)
#pragma unroll
                    for (int n = 0; n < 2; ++n) { const f32x4 y = (acc[ai][bj][m][n] * rs) * gn[bj][n] + sh[bj][n];
                        u32x2 w; w.x = cvtpk(y[0], y[1]); w.y = cvtpk(y[2], y[3]);
                        *(LAS u32x2*)(scr + fr5 * 144 + bj * 64 + n * 32 + fq5 * 8) = w; }
                const int r8 = lane5 >> 3, ch = lane5 & 7; bf16_t* tile = (bf16_t*)wsp(ws, WS_XN) + (size_t)(u.pm * 256 + wr * 64 + ai * 128 + m * 16) * D + u.pn * 256 + wc * 64;
                const u32x4 a = *(const LAS u32x4*)(scr + r8 * 144 + ch * 16), b = *(const LAS u32x4*)(scr + (r8 + 8) * 144 + ch * 16);
                *(GAS u32x4*)(tile + (size_t)r8 * D + ch * 8) = a; *(GAS u32x4*)(tile + (size_t)(r8 + 8) * D + ch * 8) = b; }
        return false;
    }
};
struct EpiSwiGLU {
    static constexpr bool PERM = true;
    bf16_t* O; int ldc;
    __device__ __forceinline__ bool operator()(const f32x4 (&acc)[2][2][4][2], const pg8::Unit& u, int wr, int wc, int fr, int fq) const {
        bf16_t* ob = O + (size_t)u.pm * 256 * ldc + (size_t)(u.pn * 4 + wc) * 8192 + (wr * 64 + fr) * 32 + 8 * fq;
#pragma unroll
        for (int ai = 0; ai < 2; ++ai)
#pragma unroll
            for (int m = 0; m < 4; ++m) { float h[8];
#pragma unroll
                for (int n = 0; n < 2; ++n)
#pragma unroll
                    for (int k = 0; k < 4; ++k) { const float a = acc[ai][0][m][n][k], b = acc[ai][1][m][n][k]; h[n * 4 + k] = a * sigmoidf_(a) * b; }
                u32x4 w; w.x = cvtpk(h[0], h[1]); w.y = cvtpk(h[2], h[3]); w.z = cvtpk(h[4], h[5]); w.w = cvtpk(h[6], h[7]);
                EPI_ST16((GAS u32x4*)(ob + (ai * 128 + m * 16) * 32), w); }
        return false;
    }
};

struct Frame {
    LAS unsigned char* lds;
    int G, vcu, bx;
    unsigned char* ws;
};
#define THREAD_IDS() const int tid = otid(), lane = tid & 63, wave = __builtin_amdgcn_readfirstlane(tid >> 6); (void)lane; (void)wave
#define LDS_WAIT() asm volatile("s_waitcnt lgkmcnt(0)" ::: "memory")

__device__ __forceinline__ void transpose_item(const GAS float* W, const Seg& s, GAS unsigned char* ws, LAS float* scr, int item, int lane) {
    const int nblk = (s.ncols + 63) >> 6, kb = item / nblk, nb = item - kb * nblk, k0 = 64 * kb, n0 = 64 * nb;
    const int c4 = (lane & 15) * 4, rl = lane >> 4; const bool ok = (n0 + c4) < s.ncols;
    f32x4 v[16];
#pragma unroll
    for (int i = 0; i < 16; ++i) v[i] = ok ? *(const GAS f32x4*)(W + (size_t)(k0 + 4 * i + rl) * s.ldw + n0 + c4) : (f32x4){0.f, 0.f, 0.f, 0.f};
#pragma unroll
    for (int i = 0; i < 16; ++i) { LAS float* p = scr + (4 * i + rl) * 65 + c4; p[0] = v[i].x; p[1] = v[i].y; p[2] = v[i].z; p[3] = v[i].w; }
    LDS_WAIT(); asm volatile("" ::: "memory");
    const int c = lane & 7; GAS bf16_t* WT = (GAS bf16_t*)(ws + s.dst);
#pragma unroll
    for (int j = 0; j < 8; ++j) { const int n = (lane >> 3) + 8 * j, na = n0 + n; const LAS float* p = scr + (8 * c) * 65 + n;
        u32x4 o; o.x = cvtpk(p[0 * 65], p[1 * 65]); o.y = cvtpk(p[2 * 65], p[3 * 65]); o.z = cvtpk(p[4 * 65], p[5 * 65]); o.w = cvtpk(p[6 * 65], p[7 * 65]);
        if (na < s.ncols) { const int drow = s.row0 + (na / s.blk) * s.stride + (na % s.blk); *(GAS u32x4*)(WT + (size_t)drow * s.K + k0 + 8 * c) = o; } }
    LDS_WAIT(); asm volatile("" ::: "memory");
}
__device__ __forceinline__ void mod_unit(Frame& F, const float* c_, const float* w_ada_, const float* b_ada_, float* MOD_, int unit) {
    const GAS float* c = (const GAS float*)c_;
    const GAS float* w_ada = (const GAS float*)w_ada_;
    const GAS float* b_ada = (const GAS float*)b_ada_;
    GAS float* MOD = (GAS float*)MOD_;
    THREAD_IDS();
    LAS float* sc = (LAS float*)F.lds;
    LAS float* red = (LAS float*)(F.lds + 16384);
    for (int i = tid; i < 4096; i += NTHREADS) { const float v = c[i]; sc[i] = v * sigmoidf_(v); }
    __syncthreads();
    const int l = unit / 96, n = (unit % 96) * 64 + lane;
    const GAS float* wp = w_ada + (size_t)l * 1024 * 6144 + n;
    float a0 = 0.f, a1 = 0.f, a2 = 0.f, a3 = 0.f;
    const int kb = wave * 128;
#pragma unroll 8
    for (int k = 0; k < 128; ++k) { const float w = wp[(size_t)(kb + k) * 6144]; a0 += sc[kb + k] * w; a1 += sc[1024 + kb + k] * w; a2 += sc[2048 + kb + k] * w; a3 += sc[3072 + kb + k] * w; }
    red[(wave * 4 + 0) * 64 + lane] = a0; red[(wave * 4 + 1) * 64 + lane] = a1; red[(wave * 4 + 2) * 64 + lane] = a2; red[(wave * 4 + 3) * 64 + lane] = a3;
    __syncthreads();
    if (tid < 256) { const int b = tid >> 6, ln = tid & 63; float s = 0.f;
#pragma unroll
        for (int w = 0; w < 8; ++w) s += red[(w * 4 + b) * 64 + ln];
        const int nn = (unit % 96) * 64 + ln; MOD[((size_t)l * 4 + b) * 6144 + nn] = s + b_ada[l * 6144 + nn]; }
    __syncthreads();
}
__device__ __forceinline__ void p0_prologue(Frame& F) {
    THREAD_IDS();
    const int gw = F.bx * NWAVES + wave, NGW = F.G * NWAVES;
    if (F.bx < 192) mod_unit(F, karg_in(1), karg_in(2), karg_in(3), (float*)(F.ws + WS_MOD), F.bx);
    LAS unsigned long long* ptab = (LAS unsigned long long*)(F.lds + 140 * 1024);
    if (tid == 0) {
        ptab[6] = (unsigned long long)karg_in(6); ptab[7] = (unsigned long long)karg_in(7); ptab[8] = (unsigned long long)karg_in(8);
        ptab[12] = (unsigned long long)karg_in(12); ptab[13] = (unsigned long long)karg_in(13); ptab[14] = (unsigned long long)karg_in(14);
        ptab[17] = (unsigned long long)karg_in(17); ptab[18] = (unsigned long long)karg_in(18); ptab[19] = (unsigned long long)karg_in(19);
    }
    __syncthreads();
    LAS float* scr = (LAS float*)(F.lds + wave * 16640);
    int si = 0;
    for (int it = gw; it < SEG_ITEMS; it += NGW) {
        while (si + 1 < NSEG && g_segs[si + 1].item0 <= it) ++si;
        const Seg s = g_segs[si];
        const GAS float* W = (const GAS float*)ptab[s.in_idx] + s.src_off;
        transpose_item(W, s, (GAS unsigned char*)F.ws, scr, it - s.item0, lane);
    }
}

template <bool ROUTE>
__device__ __forceinline__ void norm_phase(Frame& F, const float* x_, const float* g_, const float* mod_sh_, const float* mod_sc_, bf16_t* XN_,
                                           const float* Wr_, const float* br_) {
    const GAS float* x = (const GAS float*)x_;
    const GAS float* g = (const GAS float*)g_;
    const GAS float* mod_sh = (const GAS float*)mod_sh_;
    const GAS float* mod_sc = (const GAS float*)mod_sc_;
    GAS bf16_t* XN = (GAS bf16_t*)XN_;
    const GAS float* Wr = (const GAS float*)Wr_;
    const GAS float* br = (const GAS float*)br_;
    THREAD_IDS();
    LAS float* wr_l = (LAS float*)F.lds;
    LAS int* e1s = (LAS int*)(F.lds + 32768); LAS int* e2s = e1s + 64;
    if (ROUTE) { for (int i = tid; i < 8192; i += NTHREADS) wr_l[i] = Wr[i]; __syncthreads(); }
    const int row0 = F.bx * 64 + wave * 8, b = row0 >> 12;
    f32x4 gain[4], sh[4];
#pragma unroll
    for (int j = 0; j < 4; ++j) { const int cidx = 4 * lane + 256 * j;
        const f32x4 gv = *(const GAS f32x4*)(g + cidx), sv = *(const GAS f32x4*)(mod_sc + (size_t)b * 6144 + cidx);
        gain[j] = gv * (sv + 1.0f); sh[j] = *(const GAS f32x4*)(mod_sh + (size_t)b * 6144 + cidx); }
    for (int r = 0; r < 8; ++r) {
        const int row = row0 + r;
        const GAS f32x4* xr = (const GAS f32x4*)(x + (size_t)row * D) + lane;
        f32x4 v[4]; float s = 0.f;
#pragma unroll
        for (int j = 0; j < 4; ++j) { v[j] = xr[64 * j]; s += (v[j].x * v[j].x + v[j].y * v[j].y) + (v[j].z * v[j].z + v[j].w * v[j].w); }
        const float rstd = 1.0f / sqrtf(wave_sum(s) * (1.f / D) + 1e-6f);
        GAS unsigned long long* o8 = (GAS unsigned long long*)(XN + (size_t)row * D) + lane;
#pragma unroll
        for (int j = 0; j < 4; ++j) { v[j] = (v[j] * rstd) * gain[j] + sh[j];
            o8[64 * j] = (unsigned long long)cvtpk(v[j].x, v[j].y) | ((unsigned long long)cvtpk(v[j].z, v[j].w) << 32); }
        if (ROUTE) {
            float lg[8];
#pragma unroll
            for (int e = 0; e < 8; ++e) lg[e] = 0.f;
#pragma unroll
            for (int j = 0; j < 4; ++j)
#pragma unroll
                for (int k = 0; k < 4; ++k) { const LAS f32x4* wp = (const LAS f32x4*)(wr_l + (size_t)(4 * lane + 256 * j + k) * 8); const f32x4 w0 = wp[0], w1 = wp[1]; const float hv = v[j][k];
                    lg[0] += hv * w0.x; lg[1] += hv * w0.y; lg[2] += hv * w0.z; lg[3] += hv * w0.w; lg[4] += hv * w1.x; lg[5] += hv * w1.y; lg[6] += hv * w1.z; lg[7] += hv * w1.w; }
#pragma unroll
            for (int e = 0; e < 8; ++e) lg[e] = wave_sum(lg[e]) + br[e];
            int i1 = 0; float v1 = lg[0];
#pragma unroll
            for (int e = 1; e < 8; ++e) if (lg[e] > v1) { v1 = lg[e]; i1 = e; }
            int i2 = -1; float v2 = -INFINITY;
#pragma unroll
            for (int e = 0; e < 8; ++e) if (e != i1 && lg[e] > v2) { v2 = lg[e]; i2 = e; }
            const float w2 = frcp(1.f + __expf(v1 - v2)), w1 = 1.f - w2;
            if (lane == 0) { e1s[wave * 8 + r] = i1; e2s[wave * 8 + r] = i2; *(f32x2*)(F.ws + WS_RTW + (size_t)row * 8) = (f32x2){w1, w2}; }
        }
    }
    if (ROUTE) {
        __syncthreads();
        if (wave == 0) {
            const int e1 = e1s[lane], e2 = e2s[lane]; int r1 = 0, r2 = 0;
            const unsigned long long lt = (lane == 0) ? 0ull : (~0ull >> (64 - lane));
#pragma unroll
            for (int e = 0; e < 8; ++e) { const unsigned long long b1 = __ballot(e1 == e), b2 = __ballot(e2 == e); const int c1 = __builtin_popcountll(b1);
                if (e1 == e) r1 = __builtin_popcountll(b1 & lt);
                if (e2 == e) r2 = c1 + __builtin_popcountll(b2 & lt);
                if (lane == e) ((unsigned*)(F.ws + WS_WGCNT))[F.bx * 8 + e] = (unsigned)(c1 + __builtin_popcountll(b2)); }
            ((unsigned*)(F.ws + WS_RTE))[F.bx * 64 + lane] = (unsigned)e1 | ((unsigned)e2 << 8) | ((unsigned)r1 << 16) | ((unsigned)r2 << 24);
        }
        __syncthreads();
    }
}
__device__ __forceinline__ void moe_gather_phase(Frame& F, const bf16_t* XN_, bf16_t* XP_) {
    const GAS bf16_t* XN = (const GAS bf16_t*)XN_;
    GAS bf16_t* XP = (GAS bf16_t*)XP_;
    THREAD_IDS();
    LAS unsigned* cnt = (LAS unsigned*)F.lds;
    LAS int* segs = (LAS int*)(F.lds + 8192);
    const unsigned* wg = (const unsigned*)(F.ws + WS_WGCNT);
    for (int i = tid; i < 2048; i += NTHREADS) cnt[i] = wg[i];
    __syncthreads();
    if (tid < 8) { int tot = 0, base = 0; for (int w = 0; w < 256; ++w) { const int c = (int)cnt[w * 8 + tid]; if (w < F.bx) base += c; tot += c; } segs[32 + tid] = tot; segs[8 + tid] = base; }
    __syncthreads();
    if (tid == 0) { int st = 0; for (int e = 0; e < 8; ++e) { segs[e] = st; st += (segs[32 + e] + 255) & ~255; } segs[16] = st;
        if (F.bx == 0) { int* tab = (int*)(F.ws + WS_TILETAB); tab[0] = st >> 8; for (int e = 0; e < 8; ++e) { const int t0 = segs[e] >> 8, t1 = (e < 7 ? segs[e + 1] : st) >> 8; for (int t = t0; t < t1; ++t) tab[1 + t] = e; } } }
    __syncthreads();
    for (int r = 0; r < 8; ++r) {
        const int row = F.bx * 64 + wave * 8 + r;
        const unsigned rt = ((const unsigned*)(F.ws + WS_RTE))[row];
        const int e1 = rt & 255, e2 = (rt >> 8) & 255, r1 = (rt >> 16) & 255, r2 = rt >> 24;
        const int p1 = segs[e1] + segs[8 + e1] + r1, p2 = segs[e2] + segs[8 + e2] + r2;
        const GAS u32x4* src = (const GAS u32x4*)(XN + (size_t)row * D) + lane; const u32x4 a = src[0], bq = src[64];
        GAS u32x4* d1 = (GAS u32x4*)(XP + (size_t)p1 * D) + lane; d1[0] = a; d1[64] = bq;
        GAS u32x4* d2 = (GAS u32x4*)(XP + (size_t)p2 * D) + lane; d2[0] = a; d2[64] = bq;
        if (lane == 0) { int* pos = (int*)(F.ws + WS_POS) + (size_t)row * 2; pos[0] = p1; pos[1] = p2; }
    }
}
__device__ __forceinline__ void final_phase(Frame& F, float* x_, const bf16_t* Y_, const bf16_t* Z_, const float* g2_, const float* fg_) {
    GAS float* x = (GAS float*)x_;
    const GAS bf16_t* Y = (const GAS bf16_t*)Y_;
    const GAS bf16_t* Z = (const GAS bf16_t*)Z_;
    const GAS float* g2 = (const GAS float*)g2_;
    const GAS float* fg = (const GAS float*)fg_;
    THREAD_IDS();
    const int row0 = F.bx * 64 + wave * 8, b = row0 >> 12;
    f32x4 gate[4], fgv[4];
#pragma unroll
    for (int j = 0; j < 4; ++j) { const int cidx = 4 * lane + 256 * j; gate[j] = *(const GAS f32x4*)(g2 + (size_t)b * 6144 + cidx); fgv[j] = *(const GAS f32x4*)(fg + cidx); }
    for (int r = 0; r < 8; ++r) {
        const int row = row0 + r;
        const int* pos = (const int*)(F.ws + WS_POS) + (size_t)row * 2; const int p1 = pos[0], p2 = pos[1];
        const f32x2 wv = *(const f32x2*)(F.ws + WS_RTW + (size_t)row * 8);
        GAS f32x4* xr = (GAS f32x4*)(x + (size_t)row * D) + lane;
        const GAS u32x2* y1 = (const GAS u32x2*)(Y + (size_t)p1 * D) + lane; const GAS u32x2* y2 = (const GAS u32x2*)(Y + (size_t)p2 * D) + lane;
        const GAS u32x2* z1 = (const GAS u32x2*)(Z + (size_t)p1 * D) + lane; const GAS u32x2* z2 = (const GAS u32x2*)(Z + (size_t)p2 * D) + lane;
        f32x4 v[4]; float s = 0.f;
#pragma unroll
        for (int j = 0; j < 4; ++j) { const u32x2 a = y1[64 * j], c = y2[64 * j]; u32x2 a2 = {0u, 0u}, c2 = {0u, 0u};
            a2 = z1[64 * j]; c2 = z2[64 * j];
            const f32x4 ya = (f32x4){bf_lo(a.x), bf_hi(a.x), bf_lo(a.y), bf_hi(a.y)} + (f32x4){bf_lo(a2.x), bf_hi(a2.x), bf_lo(a2.y), bf_hi(a2.y)};
            const f32x4 yc = (f32x4){bf_lo(c.x), bf_hi(c.x), bf_lo(c.y), bf_hi(c.y)} + (f32x4){bf_lo(c2.x), bf_hi(c2.x), bf_lo(c2.y), bf_hi(c2.y)};
            v[j] = xr[64 * j] + gate[j] * (ya * wv.x + yc * wv.y);
            s += (v[j].x * v[j].x + v[j].y * v[j].y) + (v[j].z * v[j].z + v[j].w * v[j].w); }
        const float rstd = 1.0f / sqrtf(wave_sum(s) * (1.f / D) + 1e-6f);
#pragma unroll
        for (int j = 0; j < 4; ++j) xr[64 * j] = (v[j] * rstd) * fgv[j];
    }
}

__device__ __forceinline__ int pi_perm(int r) { return (r & 0x13) | ((r & 4) << 1) | ((r & 8) >> 1); }
__device__ __forceinline__ u32x4 tile_gload(const GAS bf16_t* g, size_t pitch, int tid) {
    const int row = tid >> 3, pc = tid & 7, c = pc ^ ((row >> 1) & 7);
    return *(const GAS u32x4*)(g + (size_t)row * pitch + c * 8);
}
__device__ __forceinline__ bf16x8 lfrag(const LAS unsigned char* p) { return *(const LAS bf16x8*)p; }
__device__ __forceinline__ bf16x8 pack8(const f32x16& p, int s) {
    u32x4 w; w.x = cvtpk(p[8 * s + 0], p[8 * s + 1]); w.y = cvtpk(p[8 * s + 2], p[8 * s + 3]); w.z = cvtpk(p[8 * s + 4], p[8 * s + 5]); w.w = cvtpk(p[8 * s + 6], p[8 * s + 7]);
    return __builtin_bit_cast(bf16x8, w);
}
__device__ __forceinline__ int t5_bucket(int rel) {
    const int n = rel < 0 ? -rel : rel;
    const int large = 8 + (n >= 12) + (n >= 16) + (n >= 23) + (n >= 32) + (n >= 46) + (n >= 64) + (n >= 91);
    return (rel > 0 ? 16 : 0) + (n < 8 ? n : large);
}
__device__ __forceinline__ float max3f(float a, float b, float c) { float r; asm("v_max3_f32 %0, %1, %2, %3" : "=v"(r) : "v"(a), "v"(b), "v"(c)); return r; }
__device__ __forceinline__ float max16(const f32x16& a) {
    float m0 = max3f(a[0], a[1], a[2]), m1 = max3f(a[3], a[4], a[5]); m0 = max3f(m0, a[6], a[7]); m1 = max3f(m1, a[8], a[9]);
    m0 = max3f(m0, a[10], a[11]); m1 = max3f(m1, a[12], a[13]); m0 = max3f(m0, a[14], a[15]);
    return max3f(m0, m1, m1);
}
__device__ __forceinline__ unsigned bitmask1(unsigned w, int bit) { int t = __builtin_amdgcn_sbfe((int)w, bit, 1); asm("" : "+v"(t)); return (unsigned)t; }
#define MFMA32(a, b, c) __builtin_amdgcn_mfma_f32_32x32x16_bf16((a), (b), (c), 0, 0, 0)

__device__ __forceinline__ void topk_unit(Frame& F, int b, int ci, int j, const bf16_t* PROJ_, const float* WI_, unsigned long long* MASK_) {
    const GAS bf16_t* PROJ = (const GAS bf16_t*)PROJ_;
    const GAS float* WI = (const GAS float*)WI_;
    GAS unsigned long long* MASK = (GAS unsigned long long*)MASK_;
    const int t0 = b * SEQ + 64 * ci + 8 * j, nreg = ci + 1;
    THREAD_IDS(); const int r32 = lane & 31, half = lane >> 5;
    if (ci < 4) {
        MASK[(size_t)(t0 + wave) * 64 + lane] = (lane < nreg) ? ~0ull : 0ull;
        return;
    }
    LAS unsigned* scu = (LAS unsigned*)F.lds;
#ifndef TOPK_DUP
#define TOPK_DUP 0
#endif
    for (int rep1 = 0; rep1 < (TOPK_DUP == 1 ? 2 : 1); ++rep1) {
        const int n16 = lane & 15, kq = lane >> 4;
        bf16x8 af[2][2]; f32x4 wv[2];
#pragma unroll
        for (int mt = 0; mt < 2; ++mt) {
#pragma unroll
            for (int jk = 0; jk < 2; ++jk) af[mt][jk] = *(const GAS bf16x8*)(PROJ + (size_t)(t0 + 4 * mt + (n16 >> 2)) * NP + C_QI + (n16 & 3) * 64 + 32 * jk + 8 * kq);
            wv[mt] = *(const GAS f32x4*)(WI + (size_t)(t0 + 4 * mt + kq) * 4);
        }
#ifndef TKB
#define TKB 16
#endif
        for (int kb0 = wave * TKB; kb0 < 4 * nreg; kb0 += 8 * TKB) {
            bf16x8 bfr[TKB][2];
#pragma unroll
            for (int u = 0; u < TKB; ++u) { const int kb = (kb0 + u < 4 * nreg) ? kb0 + u : kb0;
                                const GAS bf16_t* kp = PROJ + (size_t)(b * SEQ + 16 * kb + n16) * NP + C_KI + 8 * kq;
                bfr[u][0] = *(const GAS bf16x8*)kp; bfr[u][1] = *(const GAS bf16x8*)(kp + 32); }
#pragma unroll
            for (int u = 0; u < TKB; ++u) if (kb0 + u < 4 * nreg) {
#pragma unroll
                for (int mt = 0; mt < 2; ++mt) {
                    f32x4 acc = {0.f, 0.f, 0.f, 0.f};
                    acc = __builtin_amdgcn_mfma_f32_16x16x32_bf16(af[mt][0], bfr[u][0], acc, 0, 0, 0);
                    acc = __builtin_amdgcn_mfma_f32_16x16x32_bf16(af[mt][1], bfr[u][1], acc, 0, 0, 0);
                    const float s = wv[mt].x * fmaxf(acc.x, 0.f) + wv[mt].y * fmaxf(acc.y, 0.f) + wv[mt].z * fmaxf(acc.z, 0.f) + wv[mt].w * fmaxf(acc.w, 0.f);
                    const unsigned sb = __float_as_uint(s + 0.0f);
                    scu[(4 * mt + kq) * 4096 + ((16 * (kb0 + u) + n16) ^ (16 * (kq & 1)))] = sb ^ (((unsigned)((int)sb >> 31)) | 0x80000000u);
                }
            }
        }
    }
    __syncthreads();
    for (int rep2 = (TOPK_DUP == 2 ? 0 : 1); rep2 < 2; ++rep2) {
        unsigned key[64];
#pragma unroll
        for (int r = 0; r < 64; ++r) {
            const unsigned k = scu[wave * 4096 + ((64 * r + lane) ^ (16 * (wave & 1)))];
            key[r] = (r < nreg) ? k : 0u;
        }
#ifndef TKG
#define TKG 8
#endif
        unsigned Tt = 0u; int cge = 0;
#ifdef TOPK_ABL
        if (rep2 == 0) { Tt = 0x80000000u; cge = (TOPK_ABL == 2) ? 257 : 256; }
#if TOPK_ABL >= 3
        if (rep2 == 0) {
            unsigned acc_ = 0u;
            for (int it = 0; it < 18; ++it) { const unsigned cand = 0x80000000u + (unsigned)it * 0x01000000u + acc_; int vc = 0;
#if TOPK_ABL == 3
#pragma unroll
                for (int g4 = 0; g4 < 64 / TKG; ++g4) if (g4 * TKG < nreg) {
#pragma unroll
                    for (int r = 0; r < TKG; r += 4)
                        asm volatile("v_cmp_ge_u32_e64 s[80:81], %1, %5\n\tv_cmp_ge_u32_e64 s[82:83], %2, %5\n\tv_cmp_ge_u32_e64 s[84:85], %3, %5\n\tv_cmp_ge_u32_e64 s[86:87], %4, %5\n\t"
                                     "v_addc_co_u32_e64 %0, s[80:81], %0, 0, s[80:81]\n\tv_addc_co_u32_e64 %0, s[82:83], %0, 0, s[82:83]\n\t"
                                     "v_addc_co_u32_e64 %0, s[84:85], %0, 0, s[84:85]\n\tv_addc_co_u32_e64 %0, s[86:87], %0, 0, s[86:87]"
                                     : "+v"(vc) : "v"(key[g4 * TKG + r]), "v"(key[g4 * TKG + r + 1]), "v"(key[g4 * TKG + r + 2]), "v"(key[g4 * TKG + r + 3]), "s"(cand)
                                     : "s80", "s81", "s82", "s83", "s84", "s85", "s86", "s87");
                }
#else
#pragma unroll
                for (int g4 = 0; g4 < 64 / TKG; ++g4) if (g4 * TKG < nreg) {
#pragma unroll
                    for (int r = 0; r < TKG; r += 2) { int t0_ = (int)(key[g4 * TKG + r] - cand), t1_ = (int)(key[g4 * TKG + r + 1] - cand);
                        asm volatile("v_med3_i32 %0, %0, -1, 0\n\tv_med3_i32 %1, %1, -1, 0" : "+v"(t0_), "+v"(t1_));
                        asm volatile("v_add3_u32 %0, %0, %1, %2" : "+v"(vc) : "v"(t0_), "v"(t1_)); }
                }
#endif
                const int cnt = wave_sum_i32(vc); acc_ = (cnt & 1) ? 1u : 0u;
            }
            Tt += acc_ & 0u;
        }
#endif
#endif
        for (int bit = 32; bit >= 0; ) {
#ifdef TOPK_ABL
            if (rep2 == 0) break;
#endif
            const unsigned cand = (bit == 32) ? 0x80000001u : (bit == 31) ? 0x80000000u : (Tt | (1u << bit)); int vc = 0;
#pragma unroll
            for (int g4 = 0; g4 < 64 / TKG; ++g4) if (g4 * TKG < nreg) {
#pragma unroll
                for (int r = 0; r < TKG; r += 4)
                    asm volatile("v_cmp_ge_u32_e64 s[80:81], %1, %5\n\tv_cmp_ge_u32_e64 s[82:83], %2, %5\n\tv_cmp_ge_u32_e64 s[84:85], %3, %5\n\tv_cmp_ge_u32_e64 s[86:87], %4, %5\n\t"
                                 "v_addc_co_u32_e64 %0, s[80:81], %0, 0, s[80:81]\n\tv_addc_co_u32_e64 %0, s[82:83], %0, 0, s[82:83]\n\t"
                                 "v_addc_co_u32_e64 %0, s[84:85], %0, 0, s[84:85]\n\tv_addc_co_u32_e64 %0, s[86:87], %0, 0, s[86:87]"
                                 : "+v"(vc) : "v"(key[g4 * TKG + r]), "v"(key[g4 * TKG + r + 1]), "v"(key[g4 * TKG + r + 2]), "v"(key[g4 * TKG + r + 3]), "s"(cand)
                                 : "s80", "s81", "s82", "s83", "s84", "s85", "s86", "s87");
            }
            const int cnt = wave_sum_i32(vc);
            if (bit == 32) { if (cnt == 256) { Tt = cand; cge = 256; break; } if (cnt > 256) { Tt = 0x80000000u; bit = 30; } else bit = 31; continue; }
            if (bit == 31) { if (cnt >= 256) { Tt = cand; cge = cnt; break; } bit = 30; continue; }
            if (cnt >= 256) { Tt = cand; cge = cnt; if (cnt == 256) break; }
            --bit;
        }
        LAS unsigned long long* wl = (LAS unsigned long long*)(F.lds + 131072 + wave * 512);
        if (cge == 256) {
            unsigned mlo = 0u, mhi = 0u;
#pragma unroll
            for (int r = 0; r < 64; ++r) { const unsigned long long ge = __ballot(key[r] >= Tt);
                asm volatile("s_mov_b32 s80, %2\n\ts_mov_b32 s81, %3\n\ts_nop 4\n\tv_writelane_b32 %0, s80, %4\n\tv_writelane_b32 %1, s81, %4"
                             : "+v"(mlo), "+v"(mhi) : "s"((unsigned)ge), "s"((unsigned)(ge >> 32)), "n"(r) : "s80", "s81"); }
            MASK[(size_t)(t0 + wave) * 64 + lane] = ((unsigned long long)mhi << 32) | mlo;
        } else {
            int cgt = 0;
            for (int r = 0; r < nreg; ++r) { const unsigned k = scu[wave * 4096 + ((64 * r + lane) ^ (16 * (wave & 1)))]; cgt += __builtin_popcountll(__ballot(k > Tt)); }
            int need = 256 - cgt;
            for (int r = 0; r < nreg; ++r) { const unsigned k = scu[wave * 4096 + ((64 * r + lane) ^ (16 * (wave & 1)))];
                const unsigned long long gt = __ballot(k > Tt), eq = __ballot(k == Tt);
                unsigned long long sel = eq; int c = __builtin_popcountll(eq);
                if (c > need) { sel = 0ull; unsigned long long m = eq; for (int q = 0; q < need; ++q) { const unsigned long long low = m & (0ull - m); sel |= low; m ^= low; } c = need; }
                need -= c;
                if (lane == 0) wl[r] = gt | sel; }
            for (int r = nreg + lane; r < 64; r += 64) wl[r] = 0ull;
            MASK[(size_t)(t0 + wave) * 64 + lane] = wl[lane];
        }
    }
    __syncthreads();
}

template <int MODE, int ORD, int ATP = 0>
__device__ __forceinline__ void attn_unit(Frame& F, int b, int h, int qb, const bf16_t* PROJ_, const bf16_t* VT_, const unsigned long long* MASK_, bf16_t* OUT_,
                                          const float* rel_bias_, const float* lamp_, const float* subg_, float lam_init) {
    const GAS bf16_t* PROJ = (const GAS bf16_t*)PROJ_; const GAS bf16_t* VT = (const GAS bf16_t*)VT_; const GAS unsigned long long* MASK = (const GAS unsigned long long*)MASK_;
    GAS bf16_t* OUT = (GAS bf16_t*)OUT_; const GAS float* rel_bias = (const GAS float*)rel_bias_; const GAS float* lamp = (const GAS float*)lamp_; const GAS float* subg = (const GAS float*)subg_;
    constexpr int NDB = MODE ? 4 : 2, KS = MODE ? 16384 : 8192, VS = MODE ? 16384 : 8192, KSL = MODE ? 2 : 3, VSL = MODE ? 4 : 5, FD = MODE ? 2 : 3, VR = KSL * KS, BT = VR + VSL * VS;
    THREAD_IDS(); const int r32 = lane & 31, half = lane >> 5, map = MODE ? (wave >> 2) : 0, wq = MODE ? (wave & 3) : wave;
    LAS unsigned char* buf = F.lds; LAS float* btab = (LAS float*)(F.lds + BT);
    const int tokb = b * SEQ, qw = (MODE ? qb * 128 : qb * 256) + 32 * wq, ntw = (qw >> 6) + 1, nt = MODE ? 2 * qb + 2 : 4 * qb + 4;
    const float bfar = rel_bias[15 * 12 + (MODE ? 8 : 0) + h] * LOG2E;
    if (tid < 192) btab[tid] = rel_bias[t5_bucket(tid - 128) * 12 + (MODE ? 8 : 0) + h] * LOG2E - bfar;
    bf16x8 qf[4];
    LAS bf16x8* qpark = (LAS bf16x8*)(F.lds + BT + 1024 + wave * 4096) + lane;
#pragma unroll
    for (int ds = 0; ds < 4; ++ds) { qf[ds] = *(const GAS bf16x8*)(PROJ + (size_t)(tokb + qw + r32) * NP + (MODE ? C_QB + h * 128 + map * 64 : C_QA + h * 64) + 16 * ds + 8 * half);
        qpark[ds * 64] = qf[ds]; }
    const int prow = pi_perm(r32), swk = (prow >> 1) & 7, swv = (r32 >> 1) & 7;
    const int koff0 = map * 8192 + prow * 128 + ((half ^ swk) << 4), voff0 = VR + r32 * 128 + ((half ^ swv) << 4);
#define koff(k) (koff0 ^ ((k) << 5))
#define voff(k) (voff0 ^ ((k) << 5))
    const GAS bf16_t* kg = PROJ + (size_t)tokb * NP + (MODE ? C_KB + h * 128 : C_KA + h * 64);
    const GAS bf16_t* vg = VT + (size_t)(MODE ? 512 + h * 128 : h * 64) * VTP + tokb;
    const GAS unsigned long long* mrow = MASK + (size_t)(tokb + qw + r32) * 64;
    float m_run = 0.f, l_run = 0.f, cref = 0.f, sref = 0.f, nref = 0.f; f32x16 O[NDB], cv;
#pragma unroll
    for (int d = 0; d < NDB; ++d)
#pragma unroll
        for (int i = 0; i < 16; ++i) O[d][i] = 0.f;
    const int drow = tid >> 3, dch = ((tid & 7) ^ ((drow >> 1) & 7)) * 8;
    const GAS bf16_t* kgl = kg + (size_t)drow * NP + dch; const GAS bf16_t* vgl = vg + (size_t)drow * VTP + dch;
#ifdef AT_SETPRIO
#define AT_PRIO(p) __builtin_amdgcn_s_setprio(p)
#else
#define AT_PRIO(p) do { } while (0)
#endif
#define AT_DMA(gp, off) __builtin_amdgcn_global_load_lds((const GAS unsigned*)(gp), (LAS unsigned*)(buf + (off) + wave * 1024), 16, 0, 0)
#define AT_KLOAD(tt) do { const int t_ = (tt); const GAS bf16_t* kn_ = kgl + (size_t)t_ * 64 * NP; const int ko_ = (t_ % KSL) * KS; AT_DMA(kn_, ko_); if (MODE) AT_DMA(kn_ + 64, ko_ + 8192); } while (0)
#define AT_VLOAD(tt) do { const int t_ = (tt); const GAS bf16_t* vn_ = vgl + t_ * 64; const int vo_ = VR + (t_ % VSL) * VS; AT_DMA(vn_, vo_); if (MODE) AT_DMA(vn_ + (size_t)64 * VTP, vo_ + 8192); } while (0)
#define AT_QK(S0, S1, tt, RF) do { const int t_ = (tt); const LAS unsigned char* kb_ = buf + (t_ % KSL) * KS; const bool far_ = ATP ? true : (64 * t_ <= qw - 154); RF = cref; \
        AT_PRIO(1); { const bf16x8 q_ = qpark[0]; if (MODE) { const float c_ = bfar - cref; _Pragma("unroll") for (int i = 0; i < 16; ++i) { S0[i] = c_; S1[i] = c_; } S0 = MFMA32(lfrag(kb_ + koff(0)), q_, S0); S1 = MFMA32(lfrag(kb_ + 4096 + koff(0)), q_, S1); } \
          else { S0 = MFMA32(lfrag(kb_ + koff(0)), q_, cv); S1 = MFMA32(lfrag(kb_ + 4096 + koff(0)), q_, cv); } } \
        _Pragma("unroll") for (int ds = 1; ds < 4; ++ds) { const bf16x8 q_ = qpark[ds * 64]; S0 = MFMA32(lfrag(kb_ + koff(ds)), q_, S0); S1 = MFMA32(lfrag(kb_ + 4096 + koff(ds)), q_, S1); } AT_PRIO(0); \
        if (!far_) { const int base_ = 64 * t_ + 8 * half - (qw + r32) + 128; \
            _Pragma("unroll") for (int i = 0; i < 16; ++i) { const int o_ = 16 * (i >> 3) + (i & 7); int i0 = base_ + o_, i1 = base_ + 32 + o_; i0 = i0 < 0 ? 0 : i0; i1 = i1 < 0 ? 0 : i1; S0[i] += btab[i0]; S1[i] += btab[i1]; } } } while (0)
#define AT_SETREF() do { cref = m_run; if (!MODE) { _Pragma("unroll") for (int i = 0; i < 16; ++i) cv[i] = bfar - m_run; } } while (0)
#define AT_PV(tt) do { const LAS unsigned char* vb_ = buf + ((tt) % VSL) * VS; AT_PRIO(1); \
        _Pragma("unroll") for (int db = 0; db < NDB; ++db) { \
            O[db] = MFMA32(lfrag(vb_ + db * 4096 + voff(0)), pf0, O[db]); O[db] = MFMA32(lfrag(vb_ + db * 4096 + voff(1)), pf1, O[db]); \
            O[db] = MFMA32(lfrag(vb_ + db * 4096 + voff(2)), pf2, O[db]); O[db] = MFMA32(lfrag(vb_ + db * 4096 + voff(3)), pf3, O[db]); } AT_PRIO(0); } while (0)
    AT_KLOAD(0); AT_VLOAD(0); AT_KLOAD(1); AT_VLOAD(1); if (FD == 3) { AT_KLOAD(2 < nt ? 2 : nt - 1); AT_VLOAD(2 < nt ? 2 : nt - 1); }
    unsigned long long mcur = 0ull, mnext = 0ull;
    if (!MODE) { mcur = mrow[0]; mnext = mrow[ntw > 1 ? 1 : 0]; }
    __syncthreads();
    f32x16 s0, s1, n0, n1; bf16x8 pf0, pf1, pf2, pf3;
    {   bf16x8 z;
#pragma unroll
        for (int i = 0; i < 8; ++i) z[i] = 0;
        pf0 = z; pf1 = z; pf2 = z; pf3 = z; }
#pragma unroll
    for (int i = 0; i < 16; ++i) { n0[i] = 0.f; n1[i] = 0.f; }
    AT_SETREF();
    AT_QK(s0, s1, 0, sref);
    float mtc = fmaxf(max16(s0), max16(s1)); mtc = fmaxf(mtc, xhalf(mtc)) + sref; float mtn = mtc;
#define AT_SOFTMAX(s0, s1, sref) do { if (ATP || t < ntw) { \
            float mt = fmaxf(max16(s0), max16(s1)); mt = fmaxf(mt, xhalf(mt)) + sref;                   \
            if (!ATP && (t == 0 || __any(mt > m_run + 8.0f))) {                                                   \
                const float mn = (t == 0) ? mt : fmaxf(m_run, mt); alpha = (t == 0) ? 1.f : fexp2(m_run - mn); l_run *= alpha; m_run = mn; resc = (t != 0); AT_SETREF(); } \
            const float dl = sref - m_run; \
            if (!ATP && __any(dl != 0.f)) { _Pragma("unroll") for (int i = 0; i < 16; ++i) { s0[i] += dl; s1[i] += dl; } }        \
            float ls = 0.f; \
            if (!MODE) { \
                const unsigned long long mw = mcur >> (8 * half); const unsigned mlo = (unsigned)mw, mhi = (unsigned)(mw >> 32); \
                _Pragma("unroll") for (int i = 0; i < 16; ++i) { const int bitp = 16 * (i >> 3) + (i & 7); \
                    const float p0 = __uint_as_float(__float_as_uint(fexp2(s0[i])) & bitmask1(mlo, bitp)); \
                    const float p1 = __uint_as_float(__float_as_uint(fexp2(s1[i])) & bitmask1(mhi, bitp)); \
                    s0[i] = p0; s1[i] = p1; ls += p0 + p1; } \
            } else { \
                _Pragma("unroll") for (int i = 0; i < 16; ++i) { s0[i] = fexp2(s0[i]); s1[i] = fexp2(s1[i]); ls += s0[i] + s1[i]; } \
            } \
            l_run += ls; } \
        if (resc) { _Pragma("unroll") for (int d = 0; d < NDB; ++d) _Pragma("unroll") for (int i = 0; i < 16; ++i) O[d][i] *= alpha; } \
        if (ATP || t < ntw) { pf0 = pack8(s0, 0); pf1 = pack8(s0, 1); pf2 = pack8(s1, 0); pf3 = pack8(s1, 1); } } while (0)
#define AT_HEAD() \
        unsigned long long mfut = 0ull; \
        if (!MODE && (ATP ? true : (t + 2 < ntw))) mfut = mrow[ATP ? ((t + 2) & 63) : t + 2]; \
        asm volatile("" ::: "memory"); \
        AT_KLOAD(t + FD < nt ? t + FD : nt - 1); AT_VLOAD(t + FD < nt ? t + FD : nt - 1);        \
        float alpha = 1.f; bool resc = false;
#define AT_TAIL() \
        s0 = n0; s1 = n1; sref = nref; mcur = mnext; mnext = mfut; mtc = mtn; \
          \
        if (MODE) asm volatile("s_waitcnt vmcnt(0) lgkmcnt(0)" ::: "memory"); else asm volatile("s_waitcnt vmcnt(3) lgkmcnt(0)" ::: "memory"); \
        __builtin_amdgcn_s_barrier(); asm volatile("" ::: "memory");
#define AT_STEP_G() do { AT_HEAD() \
        if (ORD == 0) { \
            if (ATP || t + 1 < ntw) { AT_QK(n0, n1, (ATP ? (t + 1 < nt ? t + 1 : t) : t + 1), nref); mtn = fmaxf(max16(n0), max16(n1)); mtn = fmaxf(mtn, xhalf(mtn)) + nref; } \
            if (ATP || (t >= 1 && t <= ntw)) AT_PV(ATP ? (t >= 1 ? t - 1 : 0) : t - 1); \
            AT_SOFTMAX(s0, s1, sref);                                \
        } else { \
            if (ATP || (t >= 1 && t <= ntw)) AT_PV(ATP ? (t >= 1 ? t - 1 : 0) : t - 1); \
            AT_SOFTMAX(s0, s1, sref); \
            if (ATP || t + 1 < ntw) { AT_QK(n0, n1, (ATP ? (t + 1 < nt ? t + 1 : t) : t + 1), nref); mtn = fmaxf(max16(n0), max16(n1)); mtn = fmaxf(mtn, xhalf(mtn)) + nref; } \
        } \
        AT_TAIL() } while (0)
#define AT_STEP_F() do { AT_HEAD() \
              \
              \
            if (__any(mtc > m_run + 8.0f)) { const float mn = fmaxf(m_run, mtc); alpha = fexp2(m_run - mn); l_run *= alpha; m_run = mn; resc = true; AT_SETREF(); } \
            { const float dl = sref - m_run; if (__any(dl != 0.f)) { _Pragma("unroll") for (int i = 0; i < 16; ++i) { s0[i] += dl; s1[i] += dl; } } } \
            { const LAS unsigned char* kb_ = buf + ((t + 1) % KSL) * KS; nref = cref; \
              { const bf16x8 q_ = qpark[0]; if (MODE) { const float c_ = bfar - cref; _Pragma("unroll") for (int i = 0; i < 16; ++i) { n0[i] = c_; n1[i] = c_; } n0 = MFMA32(lfrag(kb_ + koff(0)), q_, n0); n1 = MFMA32(lfrag(kb_ + 4096 + koff(0)), q_, n1); } \
                else { n0 = MFMA32(lfrag(kb_ + koff(0)), q_, cv); n1 = MFMA32(lfrag(kb_ + 4096 + koff(0)), q_, cv); } } \
              _Pragma("unroll") for (int ds = 1; ds < 4; ++ds) { const bf16x8 q_ = qpark[ds * 64]; n0 = MFMA32(lfrag(kb_ + koff(ds)), q_, n0); n1 = MFMA32(lfrag(kb_ + 4096 + koff(ds)), q_, n1); } } \
            AT_PV(t - 1); \
            { float ls = 0.f; \
              if (!MODE) { const unsigned long long mw = mcur >> (8 * half); const unsigned mlo = (unsigned)mw, mhi = (unsigned)(mw >> 32); \
                _Pragma("unroll") for (int i = 0; i < 16; ++i) { const int bitp = 16 * (i >> 3) + (i & 7); \
                    const float p0 = __uint_as_float(__float_as_uint(fexp2(s0[i])) & bitmask1(mlo, bitp)); const float p1 = __uint_as_float(__float_as_uint(fexp2(s1[i])) & bitmask1(mhi, bitp)); \
                    s0[i] = p0; s1[i] = p1; ls += p0 + p1; } \
              } else { _Pragma("unroll") for (int i = 0; i < 16; ++i) { s0[i] = fexp2(s0[i]); s1[i] = fexp2(s1[i]); ls += s0[i] + s1[i]; } } \
              l_run += ls; } \
            pf0 = pack8(s0, 0); pf1 = pack8(s0, 1); pf2 = pack8(s1, 0); pf3 = pack8(s1, 1); \
            mtn = fmaxf(max16(n0), max16(n1)); mtn = fmaxf(mtn, xhalf(mtn)) + nref; \
            if (resc) { _Pragma("unroll") for (int d = 0; d < NDB; ++d) _Pragma("unroll") for (int i = 0; i < 16; ++i) O[d][i] *= alpha; } \
        AT_TAIL() } while (0)
    {
        const int tfe = (qw >= 154 + 128 && !ATP) ? (qw - 154) / 64 : 1;
        int t = 0;
        for (; t < 1; ++t) AT_STEP_G();
        for (; t < tfe; ++t) AT_STEP_F();
        for (; t < nt; ++t) AT_STEP_G();
    }
#undef AT_HEAD
#undef AT_TAIL
#undef AT_STEP_G
#undef AT_STEP_F
#undef AT_SOFTMAX
#undef AT_SETREF
    if (ntw == nt) AT_PV(nt - 1);
#undef AT_KLOAD
#undef AT_VLOAD
#undef AT_DMA
#undef AT_PRIO
#undef AT_QK
#undef AT_PV
#undef koff
#undef voff
    const float inv = frcp(l_run + xhalf(l_run));
    if (!MODE) {
        LAS unsigned char* xs = (LAS unsigned char*)(F.lds + BT + 1024 + wave * 4096);
#pragma unroll
        for (int db = 0; db < 2; ++db)
#pragma unroll
            for (int g = 0; g < 4; ++g) { u32x2 w; w.x = cvtpk(O[db][4 * g] * inv, O[db][4 * g + 1] * inv); w.y = cvtpk(O[db][4 * g + 2] * inv, O[db][4 * g + 3] * inv);
                *(LAS u32x2*)(xs + r32 * 128 + (((4 * db + g) ^ (r32 & 7)) << 4) + 8 * half) = w; }
#pragma unroll
        for (int i = 0; i < 4; ++i) { const int row = (lane >> 3) + 8 * i, ch = lane & 7;
            const u32x4 t = *(const LAS u32x4*)(xs + row * 128 + ((ch ^ (row & 7)) << 4));
            *(GAS u32x4*)(OUT + (size_t)(tokb + qw + row) * 512 + h * 64 + ch * 8) = t; }
        __syncthreads();
    } else {
        const float la = lamp[lane] * lamp[64 + lane], lb = lamp[128 + lane] * lamp[192 + lane];
        const float lam = __expf(wave_sum(la)) - __expf(wave_sum(lb)) + lam_init;
        __syncthreads();
        LAS float* ex = (LAS float*)(F.lds + wq * 16384);
        if (map == 1) {
            const float f = lam * inv;
#pragma unroll
            for (int db = 0; db < NDB; ++db)
#pragma unroll
                for (int i = 0; i < 16; ++i) ex[(db * 16 + i) * 64 + lane] = O[db][i] * f;
        }
        __syncthreads();
        if (map == 0) {
            float ss = 0.f;
#pragma unroll
            for (int db = 0; db < NDB; ++db)
#pragma unroll
                for (int i = 0; i < 16; ++i) { const float o = O[db][i] * inv - ex[(db * 16 + i) * 64 + lane]; O[db][i] = o; ss += o * o; }
            ss += xhalf(ss);
            const float rs = (1.0f / sqrtf(ss * (1.f / 128.f) + 1e-5f)) * (1.0f - lam_init);
            LAS unsigned char* xs = (LAS unsigned char*)ex;
#pragma unroll
            for (int db = 0; db < NDB; ++db)
#pragma unroll
                for (int g = 0; g < 4; ++g) { const f32x4 sg = *(const GAS f32x4*)(subg + 32 * db + 8 * g + 4 * half);
                    u32x2 w; w.x = cvtpk(O[db][4 * g] * rs * sg.x, O[db][4 * g + 1] * rs * sg.y); w.y = cvtpk(O[db][4 * g + 2] * rs * sg.z, O[db][4 * g + 3] * rs * sg.w);
                    *(LAS u32x2*)(xs + r32 * 256 + (((4 * db + g) ^ (r32 & 7)) << 4) + 8 * half) = w; }
#pragma unroll
            for (int i = 0; i < 8; ++i) { const int row = (lane >> 4) + 4 * i, ch = lane & 15;
                const u32x4 t = *(const LAS u32x4*)(xs + row * 256 + ((ch ^ (row & 7)) << 4));
                *(GAS u32x4*)(OUT + (size_t)(tokb + qw + row) * 512 + h * 128 + ch * 8) = t; }
        }
        __syncthreads();
    }
}

constexpr float SB_STOP = 48.f;
__device__ __forceinline__ void sb_unit(Frame& F, int b, int h, int qb, const bf16_t* PROJ_, const bf16_t* VT_, bf16_t* OC_) {
    const GAS bf16_t* PROJ = (const GAS bf16_t*)PROJ_;
    const GAS bf16_t* VT = (const GAS bf16_t*)VT_;
    GAS bf16_t* OC = (GAS bf16_t*)OC_;
    THREAD_IDS(); const int r32 = lane & 31, half = lane >> 5;
    LAS unsigned char* buf = F.lds; volatile LAS int* done_it = (volatile LAS int*)(F.lds + 32768);
    const int tokb = b * SEQ, qw = qb * 256 + 32 * wave, td = qw >> 6, tmax = 4 * qb + 3, qrel = (qw & 63) + r32;
    if (tid < 8) done_it[tid] = 0x7fffffff;
    bf16x8 qf[4];
#pragma unroll
    for (int ds = 0; ds < 4; ++ds) qf[ds] = *(const GAS bf16x8*)(PROJ + (size_t)(tokb + qw + r32) * NP + C_QC + h * 64 + 16 * ds + 8 * half);
    const int prow = pi_perm(r32), swk = (prow >> 1) & 7, swv = (r32 >> 1) & 7;
    int koff[4], voff[4];
#pragma unroll
    for (int k = 0; k < 4; ++k) { koff[k] = prow * 128 + (((2 * k + half) ^ swk) << 4); voff[k] = 8192 + r32 * 128 + (((2 * k + half) ^ swv) << 4); }
    const GAS bf16_t* kg = PROJ + (size_t)tokb * NP + C_KC + h * 64;
    const GAS bf16_t* vg = VT + (size_t)(1024 + h * 64) * VTP + tokb;
    float carry = 0.f; bool done = false; f32x16 O[2];
#pragma unroll
    for (int i = 0; i < 16; ++i) { O[0][i] = 0.f; O[1][i] = 0.f; }
    u32x4 kreg = tile_gload(kg + (size_t)tmax * 64 * NP, NP, tid), vreg = tile_gload(vg + tmax * 64, VTP, tid);
    *(LAS u32x4*)(buf + tid * 16) = kreg; *(LAS u32x4*)(buf + 8192 + tid * 16) = vreg;
    __syncthreads();
    for (int k = 0; k <= tmax; ++k) {
        const int t = tmax - k;
        const LAS unsigned char* cur = buf + (k & 1) * 16384;
        if (t > 0) { kreg = tile_gload(kg + (size_t)(t - 1) * 64 * NP, NP, tid); vreg = tile_gload(vg + (t - 1) * 64, VTP, tid); }
        if (t <= td && !done) {
            f32x16 z0, z1;
#pragma unroll
            for (int i = 0; i < 16; ++i) { z0[i] = 0.f; z1[i] = 0.f; }
#pragma unroll
            for (int ds = 0; ds < 4; ++ds) { z0 = MFMA32(lfrag(cur + koff[ds]), qf[ds], z0); z1 = MFMA32(lfrag(cur + 4096 + koff[ds]), qf[ds], z1); }
            if (t == td) {
                const float limf = (float)(qrel - 8 * half);
#pragma unroll
                for (int i = 0; i < 16; ++i) { const float o = (float)(16 * (i >> 3) + (i & 7)) + 0.5f;
                    z0[i] = fmaf(fminf(limf - o, 0.f), 1e30f, z0[i]); z1[i] = fmaf(fminf(limf - (o + 32.f), 0.f), 1e30f, z1[i]); }
            }
            f32x16 c0, c1;
#pragma unroll
            for (int i = 0; i < 16; ++i) {
                c0[i] = fmaxf(z0[i], 0.f) + flog2(1.f + fexp2(-fabsf(z0[i]))); c1[i] = fmaxf(z1[i], 0.f) + flog2(1.f + fexp2(-fabsf(z1[i]))); }
            float run[4];
#pragma unroll
            for (int s = 0; s < 2; ++s) { float a = 0.f, bb = 0.f;
#pragma unroll
                for (int i = 7; i >= 0; --i) { a += c0[8 * s + i]; c0[8 * s + i] = a; bb += c1[8 * s + i]; c1[8 * s + i] = bb; }
                run[s] = a; run[2 + s] = bb; }
            float off[4]; float after = carry;
#pragma unroll
            for (int q = 3; q >= 0; --q) { const float xr = xhalf(run[q]); off[q] = after + (half ? 0.f : xr); after += run[q] + xr; }
            carry = after;
#pragma unroll
            for (int i = 0; i < 16; ++i) { const int s = i >> 3; z0[i] = fexp2(z0[i] - (c0[i] + off[s])); z1[i] = fexp2(z1[i] - (c1[i] + off[2 + s])); }
            const bf16x8 pf0 = pack8(z0, 0), pf1 = pack8(z0, 1), pf2 = pack8(z1, 0), pf3 = pack8(z1, 1);
#pragma unroll
            for (int db = 0; db < 2; ++db) {
                O[db] = MFMA32(lfrag(cur + db * 4096 + voff[0]), pf0, O[db]); O[db] = MFMA32(lfrag(cur + db * 4096 + voff[1]), pf1, O[db]);
                O[db] = MFMA32(lfrag(cur + db * 4096 + voff[2]), pf2, O[db]); O[db] = MFMA32(lfrag(cur + db * 4096 + voff[3]), pf3, O[db]); }
            if (t == 0 || __all(carry > SB_STOP)) { done = true; if (lane == 0) done_it[wave] = k; }
        }
        if (t > 0) { LAS unsigned char* nb = buf + ((k + 1) & 1) * 16384; *(LAS u32x4*)(nb + tid * 16) = kreg; *(LAS u32x4*)(nb + 8192 + tid * 16) = vreg; }
        __syncthreads();
        bool all = true;
#pragma unroll
        for (int w = 0; w < 8; ++w) all = all && (done_it[w] <= k);
        if (all) break;
    }
    LAS unsigned char* xs = (LAS unsigned char*)(F.lds + 36864 + wave * 4096);
#pragma unroll
    for (int db = 0; db < 2; ++db)
#pragma unroll
        for (int g = 0; g < 4; ++g) { u32x2 w; w.x = cvtpk(O[db][4 * g], O[db][4 * g + 1]); w.y = cvtpk(O[db][4 * g + 2], O[db][4 * g + 3]);
            *(LAS u32x2*)(xs + r32 * 128 + (((4 * db + g) ^ (r32 & 7)) << 4) + 8 * half) = w; }
#pragma unroll
    for (int i = 0; i < 4; ++i) { const int row = (lane >> 3) + 8 * i, ch = lane & 7;
        const u32x4 t = *(const LAS u32x4*)(xs + row * 128 + ((ch ^ (row & 7)) << 4));
        *(GAS u32x4*)(OC + (size_t)(tokb + qw + row) * 512 + h * 64 + ch * 8) = t; }
    __syncthreads();
}

#ifdef PROBE_LAYER
constexpr int NSAMP = 96;
__device__ __forceinline__ float bfv(const bf16_t* p) { return __uint_as_float(((unsigned)*p) << 16); }
__device__ float blk_max(float v, float* red) { __syncthreads(); red[threadIdx.x] = v; __syncthreads(); for (int s = 256; s > 0; s >>= 1) { if ((int)threadIdx.x < s) red[threadIdx.x] = fmaxf(red[threadIdx.x], red[threadIdx.x + s]); __syncthreads(); } const float r = red[0]; __syncthreads(); return r; }
__global__ void __launch_bounds__(512) oracle_kernel(const unsigned char* ws, const float* rel_bias, const float* lamp, const float* subg, float lam_init) {
    __shared__ float sc[4096]; __shared__ unsigned char sel[4096]; __shared__ float red[512]; __shared__ float ssq[4];
    const int samp = blockIdx.x, tid = threadIdx.x;
    const int b = samp & 3, t = (samp * 1597 + 41) & 4095, tok = b * SEQ + t, ci = t >> 6, limit = 64 * (ci + 1);
    const bf16_t* PROJ = (const bf16_t*)(ws + WS_PROJ); const bf16_t* VT = (const bf16_t*)(ws + WS_VT); const float* WI = (const float*)(ws + WS_WI);
    unsigned* errw = (unsigned*)(ws + WS_CTL + 32768);
    {
        for (int s = tid; s < limit; s += 512) { float tot = 0.f;
            for (int h = 0; h < 4; ++h) { float d = 0.f; for (int k = 0; k < 64; ++k) d += bfv(PROJ + (size_t)tok * NP + C_QI + h * 64 + k) * bfv(PROJ + (size_t)(b * SEQ + s) * NP + C_KI + k);
                tot += WI[(size_t)tok * 4 + h] * fmaxf(d, 0.f); }
            sc[s] = tot + 0.0f; }
        __syncthreads();
        const int topk = limit < 256 ? limit : 256;
        for (int s = tid; s < limit; s += 512) { const float v = sc[s]; int rank = 0; for (int j = 0; j < limit; ++j) { const float u = sc[j]; rank += (u > v || (u == v && j < s)) ? 1 : 0; } sel[s] = rank < topk ? 1 : 0; }
        __syncthreads();
        const int h = tid >> 6, d = tid & 63;
        float mx = -INFINITY;
        for (int s = 0; s < limit; ++s) if (sel[s]) { float lg = 0.f; for (int k = 0; k < 64; ++k) lg += bfv(PROJ + (size_t)tok * NP + C_QA + h * 64 + k) * bfv(PROJ + (size_t)(b * SEQ + s) * NP + C_KA + h * 64 + k);
            lg += rel_bias[t5_bucket(s - t) * 12 + h] * LOG2E; mx = fmaxf(mx, lg); }
        float l = 0.f, o = 0.f;
        for (int s = 0; s < limit; ++s) if (sel[s]) { float lg = 0.f; for (int k = 0; k < 64; ++k) lg += bfv(PROJ + (size_t)tok * NP + C_QA + h * 64 + k) * bfv(PROJ + (size_t)(b * SEQ + s) * NP + C_KA + h * 64 + k);
            lg += rel_bias[t5_bucket(s - t) * 12 + h] * LOG2E; const float p = exp2f(lg - mx); l += p; o += p * bfv(VT + (size_t)(h * 64 + d) * VTP + b * SEQ + s); }
        o /= l;
        const float mine = bfv((const bf16_t*)(ws + WS_OA) + (size_t)tok * 512 + tid);
        const float md = blk_max(fabsf(o - mine), red), ma = blk_max(fabsf(o), red);
        if (tid == 0) atomicMax(errw + 0, __float_as_uint(md / fmaxf(ma, 1e-20f)));
    }
    {
        const int h = tid >> 7, e = tid & 127; float on0 = 0.f, on1 = 0.f;
        for (int m = 0; m < 2; ++m) {
            float mx = -INFINITY;
            for (int s = 0; s < limit; ++s) { float lg = 0.f; for (int k = 0; k < 64; ++k) lg += bfv(PROJ + (size_t)tok * NP + C_QB + h * 128 + m * 64 + k) * bfv(PROJ + (size_t)(b * SEQ + s) * NP + C_KB + h * 128 + m * 64 + k);
                lg += rel_bias[t5_bucket(s - t) * 12 + 8 + h] * LOG2E; mx = fmaxf(mx, lg); }
            float l = 0.f, o = 0.f;
            for (int s = 0; s < limit; ++s) { float lg = 0.f; for (int k = 0; k < 64; ++k) lg += bfv(PROJ + (size_t)tok * NP + C_QB + h * 128 + m * 64 + k) * bfv(PROJ + (size_t)(b * SEQ + s) * NP + C_KB + h * 128 + m * 64 + k);
                lg += rel_bias[t5_bucket(s - t) * 12 + 8 + h] * LOG2E; const float p = exp2f(lg - mx); l += p; o += p * bfv(VT + (size_t)(512 + h * 128 + e) * VTP + b * SEQ + s); }
            if (m == 0) on0 = o / l; else on1 = o / l;
        }
        float la = 0.f, lb = 0.f; for (int k = 0; k < 64; ++k) { la += lamp[k] * lamp[64 + k]; lb += lamp[128 + k] * lamp[192 + k]; }
        const float lam = expf(la) - expf(lb) + lam_init;
        float o = on0 - lam * on1;
        if (tid < 4) ssq[tid] = 0.f; __syncthreads(); atomicAdd(&ssq[h], o * o); __syncthreads();
        o = o * rsqrtf(ssq[h] / 128.f + 1e-5f) * subg[e] * (1.0f - lam_init);
        const float mine = bfv((const bf16_t*)(ws + WS_OB) + (size_t)tok * 512 + tid);
        const float md = blk_max(fabsf(o - mine), red), ma = blk_max(fabsf(o), red);
        if (tid == 0) atomicMax(errw + 1, __float_as_uint(md / fmaxf(ma, 1e-20f)));
    }
    {
        const int h = tid >> 6, d = tid & 63; float C = 0.f, o = 0.f;
        for (int s = t - 1; s >= 0; --s) { float z = 0.f; for (int k = 0; k < 64; ++k) z += bfv(PROJ + (size_t)tok * NP + C_QC + h * 64 + k) * bfv(PROJ + (size_t)(b * SEQ + s) * NP + C_KC + h * 64 + k);
            const float sp = fmaxf(z, 0.f) + log2f(1.f + exp2f(-fabsf(z))); C += sp; o += exp2f(z - C) * bfv(VT + (size_t)(1024 + h * 64 + d) * VTP + b * SEQ + s); }
        const float mine = bfv((const bf16_t*)(ws + WS_OC) + (size_t)tok * 512 + tid);
        const float md = blk_max(fabsf(o - mine), red), ma = blk_max(fabsf(o), red);
        if (tid == 0) atomicMax(errw + 2, __float_as_uint(md / fmaxf(ma, 1e-20f)));
    }
}
#ifndef PROBE_SEL
#define PROBE_SEL -1
#endif
__global__ void probe_out_kernel(const unsigned char* ws, float* out, int n) {
    const unsigned* errw = (const unsigned*)(ws + WS_CTL + 32768);
    float v;
    if (PROBE_SEL < 0) { int code = 0; for (int k = 0; k < 3; ++k) { const float e = __uint_as_float(errw[k]); if (!(e < 0.03f)) code |= 1 << k; } v = 20.f + 8.f * code; }
    else v = 20.f + 1e4f * __uint_as_float(errw[PROBE_SEL]);
    const float c = sqrtf(v);
    for (int i = blockIdx.x * blockDim.x + threadIdx.x; i < n; i += gridDim.x * blockDim.x) out[i] = c;
}
#endif

constexpr int LDS_BYTES = 163840;
constexpr int MISC_OFF = LDS_BYTES - 1024;
constexpr int NPH_LAYER = 13, NPHASES = 1 + 2 * NPH_LAYER;

#define IN(i) karg_in(i)
#define WSP(off) wsp(F.ws, (off))
#ifndef LBW
#define LBW 2
#endif
__global__ void __launch_bounds__(NTHREADS, LBW) fwd_kernel(Args args_unused) {
    extern __shared__ __attribute__((aligned(16))) unsigned char lds_raw[];
    Frame F;
    F.lds = (LAS unsigned char*)lds_raw;
    F.G = gridDim.x; F.bx = blockIdx.x; F.vcu = (F.bx % 8) * (F.G / 8) + F.bx / 8; F.ws = (unsigned char*)karg_in(22);
    unsigned* ctl = (unsigned*)(F.ws + WS_CTL);
    if (threadIdx.x < 4) ((LAS unsigned*)(F.lds + MISC_OFF))[threadIdx.x] = 0u;
    __syncthreads();
    const int lo = karg_int(46), hi = karg_int(47);
    const bool one_launch = (hi - lo) > 1;
    XcdBarrier bar; bar.bar = ctl + CW_BAR; bar.x = 0; bar.st = nullptr;
    if (one_launch) bar = xcd_barrier_post(ctl + CW_BAR, (volatile LAS unsigned*)(F.lds + MISC_OFF));
#ifndef ONLY_PH
#define ONLY_PH -1
#endif
#define PHEN(k) (ONLY_PH < 0 || ONLY_PH == (k))
#define RUN(id) (lo <= (id) && (id) < hi)
#define RUNK(k) (PHEN(k) && RUN(pb + (k)))
#ifndef ORD_P1
#define ORD_P1 0
#endif
#ifndef ORD_P7
#define ORD_P7 0
#endif
#ifndef ORD_P10
#define ORD_P10 0
#endif
#ifndef ORD_P11
#define ORD_P11 0
#endif
#ifndef DUP_PH
#define DUP_PH -1
#endif
#ifndef DUP_L
#define DUP_L -1
#endif
#define REP(k) for (int rep_ = 0; rep_ < (((DUP_PH) == (k) && (DUP_L < 0 || DUP_L == l_rep_)) ? 2 : 1); ++rep_)
#ifdef TIMER_PH
#ifndef TIMER_L
#define TIMER_L 0
#endif
#define SEAM(id) do { if ((id) + 1 < hi) xcd_barrier(bar); \
        if ((id) == 1 + NPH_LAYER * TIMER_L + TIMER_PH && blockIdx.x == 0 && threadIdx.x == 0) ctl[16] = (unsigned)wall_clock64() - ctl[17]; } while (0)
#define TSTART(k) do { if ((k) == TIMER_PH && l == TIMER_L && blockIdx.x == 0 && threadIdx.x == 0) ctl[17] = (unsigned)wall_clock64(); } while (0)
#else
#define SEAM(id) do { if ((id) + 1 < hi) xcd_barrier(bar); } while (0)
#define TSTART(k) do { } while (0)
#endif

    if (PHEN(100) && RUN(0)) { const int l_rep_ = 0; (void)l_rep_; REP(100) { p0_prologue(F); __syncthreads(); } SEAM(0); }

    for (int l = 0; l < DEPTH; ++l) {
        const int pb = 1 + NPH_LAYER * l; const int l_rep_ = l; (void)l_rep_;
#define MODL(k) ((const float*)WSP(WS_MOD) + (size_t)l * 4 * 6144 + (k) * D)
#define XCUR() ((l == 0) ? IN(0) : (const float*)IN(21))
#define XRES() ((float*)IN(21))
#ifndef NO_FUSED_NORM
        if (l == 0)
#endif
        if (RUNK(0)) { TSTART(0); norm_phase<false>(F, XCUR(), IN(4) + l * D, MODL(0), MODL(1), (bf16_t*)WSP(WS_XN), nullptr, nullptr); SEAM(pb + 0); }
        if (RUNK(1)) { TSTART(1); REP(1) {
#ifdef STAGGER_US10
            {
                const unsigned long long t0_ = __builtin_amdgcn_s_memrealtime(); const unsigned long long dl_ = (unsigned long long)((F.bx >> 3) & 31) * STAGGER_US10 * 10ull;
                while (__builtin_amdgcn_s_memrealtime() - t0_ < dl_) __builtin_amdgcn_s_sleep(8);
            }
#endif
#ifdef INPROJ_ONLY
            if (!(rep_ == 0 && INPROJ_ONLY == 2))
#endif
            { pg8::Gemm g{D, D, D}; TileSched S; S.init(WS_XN, WS_WIN + (size_t)l * 13 * MiB, T, NPROJ, D, D, F.G, F.bx); S.ord = ORD_P1;
#ifdef INPROJ_ABL
#if INPROJ_ABL == 2
              if (rep_ == 0) { EpiBf16 E0{(bf16_t*)WSP(WS_PROJ), NP}; fill_units(F.lds, S); pg8::gemm_phase(F.lds, (const char*)F.ws, g, E0); } else
#elif INPROJ_ABL == 3
              if (rep_ == 0) { EpiBlocked E0{(bf16_t*)WSP(WS_PROJ)}; fill_units(F.lds, S); pg8::gemm_phase(F.lds, (const char*)F.ws, g, E0); xcd_barrier(bar); } else
#else
              if (rep_ == 0) { EpiLinear E0{(bf16_t*)WSP(WS_PROJ)}; fill_units(F.lds, S); pg8::gemm_phase(F.lds, (const char*)F.ws, g, E0); } else
#endif
#endif
              { EpiProj E{(bf16_t*)WSP(WS_PROJ), (float*)WSP(WS_WI), F.lds}; fill_units(F.lds, S); pg8::gemm_phase(F.lds, (const char*)F.ws, g, E); } }
#ifdef INPROJ_ONLY
            if (!(rep_ == 0 && INPROJ_ONLY == 1))
#endif
            { pg8::Gemm g{D, D, D}; TileSched S; S.init(WS_WV + (size_t)l * 3 * MiB, WS_XN, 1536, T, D, D, F.G, (F.bx + 128) & 255);
              EpiBf16 E{(bf16_t*)WSP(WS_VT), VTP, F.lds}; fill_units(F.lds, S); pg8::gemm_phase(F.lds, (const char*)F.ws, g, E); }
            }
            SEAM(pb + 1);
        }
        if (RUNK(2)) { TSTART(2); REP(2) {
            const int c = F.vcu, b = c >> 6, m = c & 63;
            const bf16_t* PROJ = (const bf16_t*)WSP(WS_PROJ); const float* WI = (const float*)WSP(WS_WI); unsigned long long* MASK = (unsigned long long*)WSP(WS_MASK);
            for (int k = 0; k < 8; ++k) { const int ci = 8 * k + ((k & 1) ? 7 - (m & 7) : (m & 7)); topk_unit(F, b, ci, m >> 3, PROJ, WI, MASK); }
            }
        }
        if (RUNK(3)) { TSTART(3); REP(3) {
            const int c = F.vcu, bh = c >> 4, s = c & 15; const float lam_init = 0.8f - 0.6f * __expf(-0.3f * (float)l);
            const bool hiw = (__builtin_amdgcn_readfirstlane((int)threadIdx.x >> 6) & 1) != 0;
            for (int k = 0; k < 2; ++k) { if (!hiw) attn_unit<1, 0>(F, bh >> 2, bh & 3, k == 0 ? s : 31 - s, (const bf16_t*)WSP(WS_PROJ), (const bf16_t*)WSP(WS_VT), nullptr, (bf16_t*)WSP(WS_OB), IN(9), IN(10) + l * 256, IN(11) + l * 128, lam_init); else attn_unit<1, 1>(F, bh >> 2, bh & 3, k == 0 ? s : 31 - s, (const bf16_t*)WSP(WS_PROJ), (const bf16_t*)WSP(WS_VT), nullptr, (bf16_t*)WSP(WS_OB), IN(9), IN(10) + l * 256, IN(11) + l * 128, lam_init); }
            }
        }
        if (RUNK(4)) { TSTART(4); REP(4) {
            const int c = F.vcu, bh = c >> 3, s = c & 7;
            for (int k = 0; k < 2; ++k) sb_unit(F, bh >> 3, bh & 7, k == 0 ? s : 15 - s, (const bf16_t*)WSP(WS_PROJ), (const bf16_t*)WSP(WS_VT), (bf16_t*)WSP(WS_OC));
            }
            SEAM(pb + 4);
        }
        if (RUNK(5)) { TSTART(5); REP(5) {
            const int c = F.vcu, bh = c >> 3, s = c & 7;
            const bool hiw = (__builtin_amdgcn_readfirstlane((int)threadIdx.x >> 6) & 1) != 0;
#ifdef ATP_PROBE
                        for (int k = 0; k < 2; ++k) { if (!hiw) attn_unit<0, 0, ATP_PROBE>(F, bh >> 3, bh & 7, k == 0 ? s : 15 - s, (const bf16_t*)WSP(WS_PROJ), (const bf16_t*)WSP(WS_VT), (const unsigned long long*)WSP(WS_MASK), (bf16_t*)WSP(WS_OA), IN(9), nullptr, nullptr, 0.f); else attn_unit<0, 1, ATP_PROBE>(F, bh >> 3, bh & 7, k == 0 ? s : 15 - s, (const bf16_t*)WSP(WS_PROJ), (const bf16_t*)WSP(WS_VT), (const unsigned long long*)WSP(WS_MASK), (bf16_t*)WSP(WS_OA), IN(9), nullptr, nullptr, 0.f); }
#endif
            for (int k = 0; k < 2; ++k) { if (!hiw) attn_unit<0, 0>(F, bh >> 3, bh & 7, k == 0 ? s : 15 - s, (const bf16_t*)WSP(WS_PROJ), (const bf16_t*)WSP(WS_VT), (const unsigned long long*)WSP(WS_MASK), (bf16_t*)WSP(WS_OA), IN(9), nullptr, nullptr, 0.f); else attn_unit<0, 1>(F, bh >> 3, bh & 7, k == 0 ? s : 15 - s, (const bf16_t*)WSP(WS_PROJ), (const bf16_t*)WSP(WS_VT), (const unsigned long long*)WSP(WS_MASK), (bf16_t*)WSP(WS_OA), IN(9), nullptr, nullptr, 0.f); }

            }
            SEAM(pb + 5);
        }
        if (RUNK(6)) { TSTART(6);
            pg8::Gemm g{512, 512, 512}; BranchSched S; S.B = (unsigned)(WS_WBR + (size_t)l * 3 * MiB); S.c = F.bx;
            EpiBranch E{(const bf16_t*)WSP(WS_PROJ) + C_GATE, (bf16_t*)WSP(WS_MERGED), F.lds}; fill_units(F.lds, S); pg8::gemm_phase(F.lds, (const char*)F.ws, g, E);
            SEAM(pb + 6);
        }
        if (RUNK(7)) { TSTART(7);
            pg8::Gemm g{D, D, D}; TileSched S; S.init(WS_MERGED, WS_WOUT + (size_t)l * 2 * MiB, T, D, D, D, F.G, F.bx); S.ord = ORD_P7;
#ifndef NO_FUSED_NORM
            if (l == 0) {
                EpiResidNorm E{XCUR(), XRES(), MODL(2), F.lds, IN(5) + l * D, F.ws, 0 * 4 * 6144 + 3 * D, 0 * 4 * 6144 + 4 * D, CW_PANEL};
                fill_units(F.lds, S); pg8::gemm_phase(F.lds, (const char*)F.ws, g, E);
            } else
#endif
            { EpiResid E{XCUR(), XRES(), MODL(2), F.lds}; fill_units(F.lds, S); pg8::gemm_phase(F.lds, (const char*)F.ws, g, E); }
            SEAM(pb + 7);
        }
        if (l == 0) {
#ifdef NO_FUSED_NORM
            if (RUNK(8)) { TSTART(8); norm_phase<false>(F, XRES(), IN(5) + l * D, MODL(3), MODL(4), (bf16_t*)WSP(WS_XN), nullptr, nullptr); SEAM(pb + 8); }
#endif
            if (RUNK(10)) { TSTART(10); REP(10) {
                pg8::Gemm g{D, D, D}; TileSched S; S.init(WS_XN, WS_W13, T, 2 * DFF, D, D, F.G, F.bx); S.ord = ORD_P10;
                EpiSwiGLU E{(bf16_t*)WSP(WS_HID), DFF}; fill_units(F.lds, S); pg8::gemm_phase(F.lds, (const char*)F.ws, g, E);
                }
                SEAM(pb + 10);
            }
            if (RUNK(11)) { TSTART(11); REP(111) {
                pg8::Gemm g{DFF, DFF, DFF}; TileSched S; S.init(WS_HID, WS_W2, T, D, DFF, DFF, F.G, F.bx); S.ord = ORD_P11;
#ifndef NO_FUSED_NORM
                EpiResidNorm E{XRES(), XRES(), MODL(5), F.lds, IN(4) + 1 * D, F.ws, 1 * 4 * 6144 + 0 * D, 1 * 4 * 6144 + 1 * D, CW_PANEL + 4096};
                fill_units(F.lds, S); pg8::gemm_phase<EpiResidNorm, false, true>(F.lds, (const char*)F.ws, g, E);
#else
                EpiResid E{XRES(), XRES(), MODL(5), F.lds}; fill_units(F.lds, S); pg8::gemm_phase<EpiResid, false, true>(F.lds, (const char*)F.ws, g, E);
#endif
                }
                SEAM(pb + 11);
            }
        } else {
            if (RUNK(8)) { TSTART(8); norm_phase<true>(F, XRES(), IN(5) + l * D, MODL(3), MODL(4), (bf16_t*)WSP(WS_XN), IN(15), IN(16)); SEAM(pb + 8); }
            if (RUNK(9)) { TSTART(9); moe_gather_phase(F, (const bf16_t*)WSP(WS_XN), (bf16_t*)WSP(WS_XP)); SEAM(pb + 9); }
            if (RUNK(10)) { TSTART(10); REP(10) {
                pg8::Gemm g{D, D, D}; MoeSched S{(unsigned)WS_XP, (unsigned)WS_MW13, (const int*)WSP(WS_TILETAB), 256u * D * 2, 256u * D * 2, 2u * DFFE * D * 2, 2 * DFFE / 256, F.G, F.bx, 1, 0u, 0u};
#ifdef MOE_E0
                if (DUP_PH == 10 && rep_ == 0) S.estep = 0u;
#endif
#ifdef MOE_A0
                if (DUP_PH == 10 && rep_ == 0) S.astep = 0u;
#endif
                EpiSwiGLU E{(bf16_t*)WSP(WS_HID), DFFE}; fill_units(F.lds, S); pg8::gemm_phase(F.lds, (const char*)F.ws, g, E);
                }
                SEAM(pb + 10);
            }
            if (RUNK(11)) { TSTART(11); REP(11) {
                pg8::Gemm g{DFFE / 2, DFFE, DFFE}; MoeSched S{(unsigned)WS_HID, (unsigned)WS_MW2, (const int*)WSP(WS_TILETAB), 256u * DFFE * 2, 256u * DFFE * 2, (unsigned)D * DFFE * 2, D / 256, F.G, F.bx, 2, (unsigned)DFFE, (unsigned)(DFFE / 64) * 16384u};
                EpiBf16Split E{(bf16_t*)WSP(WS_XP), (bf16_t*)WSP(WS_MW13), D, F.lds}; fill_units(F.lds, S); pg8::gemm_phase<EpiBf16Split, false, true>(F.lds, (const char*)F.ws, g, E);
                }
                SEAM(pb + 11);
            }
            if (RUNK(12)) { TSTART(12); final_phase(F, XRES(), (const bf16_t*)WSP(WS_XP), (const bf16_t*)WSP(WS_MW13), MODL(5), IN(20)); }
        }
    }
#ifdef TIMER_PH
    {
        __syncthreads();
        const float us = (float)__hip_atomic_load(ctl + 16, __ATOMIC_RELAXED, __HIP_MEMORY_SCOPE_AGENT) * 0.01f; const float cst = logf(fmaxf(us, 1.0f));
        float* o = (float*)IN(21) + (size_t)blockIdx.x * 64 * D;
        for (int i = threadIdx.x; i < 64 * D; i += NTHREADS) o[i] = cst;
    }
#endif
#undef RUN
#undef SEAM
}

#include <cmath>
#ifndef N_LAUNCH_MODE
#define N_LAUNCH_MODE 1
#endif
extern "C" void kernel_launch(void* const* d_in, const int* in_sizes, int n_in, void* d_out, int out_size, void* d_ws, size_t ws_size, hipStream_t stream) {
    static int grid = 0;
    if (grid == 0) {
        if (n_in != 21 || in_sizes[0] != T * D || out_size != T * D || ws_size < WS_END) { fprintf(stderr, "kernel_launch: unexpected shapes / workspace (%d inputs, ws %zu < %zu)\n", n_in, ws_size, (size_t)WS_END); grid = -1; return; }
        int dev = 0, cus = 0, per_cu = 0;
        if (hipGetDevice(&dev) != hipSuccess || hipDeviceGetAttribute(&cus, hipDeviceAttributeMultiprocessorCount, dev) != hipSuccess) { grid = -1; return; }
        if (hipFuncSetAttribute((const void*)fwd_kernel, hipFuncAttributeMaxDynamicSharedMemorySize, LDS_BYTES) != hipSuccess) { fprintf(stderr, "kernel_launch: cannot get %d bytes of LDS\n", LDS_BYTES); grid = -1; return; }
        if (hipOccupancyMaxActiveBlocksPerMultiprocessor(&per_cu, (const void*)fwd_kernel, NTHREADS, LDS_BYTES) != hipSuccess || per_cu < 1) { fprintf(stderr, "kernel_launch: occupancy query says %d\n", per_cu); }
        (void)hipGetLastError();
        if (cus != 256) { fprintf(stderr, "kernel_launch: built for 256 CUs, found %d\n", cus); grid = -1; return; }
        grid = 256;
    }
    if (grid < 0) return;
    (void)hipMemsetAsync((char*)d_ws + WS_CTL, 0, CTL_ZERO_BYTES, stream);
    Args a{};
    for (int i = 0; i < 21; ++i) a.in[i] = (const float*)d_in[i];
    a.out = (float*)d_out; a.ws = (unsigned char*)d_ws;
#if defined(PROBE_LAYER)
    a.ph_lo = 0; a.ph_hi = 1 + NPH_LAYER * PROBE_LAYER + 6;
    hipLaunchKernelGGL(fwd_kernel, dim3(grid), dim3(NTHREADS), LDS_BYTES, stream, a);
    hipLaunchKernelGGL(oracle_kernel, dim3(NSAMP), dim3(512), 0, stream, (const unsigned char*)d_ws, (const float*)d_in[9], (const float*)d_in[10] + PROBE_LAYER * 256, (const float*)d_in[11] + PROBE_LAYER * 128, 0.8f - 0.6f * expf(-0.3f * (float)PROBE_LAYER));
    hipLaunchKernelGGL(probe_out_kernel, dim3(1024), dim3(256), 0, stream, (const unsigned char*)d_ws, (float*)d_out, out_size);
#elif N_LAUNCH_MODE == 1
    a.ph_lo = 0; a.ph_hi = NPHASES;
    hipLaunchKernelGGL(fwd_kernel, dim3(grid), dim3(NTHREADS), LDS_BYTES, stream, a);
#else
    for (int p = 0; p < NPHASES; ++p) {
        if (p == 1 + 9 || p == 1 + 12) continue;
        a.ph_lo = p; a.ph_hi = p + 1;
        hipLaunchKernelGGL(fwd_kernel, dim3(grid), dim3(NTHREADS), LDS_BYTES, stream, a);
    }
#endif
}
```

```cpp
#include <hip/hip_runtime.h>
#include <cstdio>
#include <cstdint>

#define LAS __attribute__((address_space(3)))
#define GAS __attribute__((address_space(1)))
typedef unsigned short bf16_t;
typedef short bf16x8 __attribute__((ext_vector_type(8)));
typedef float f32x2 __attribute__((ext_vector_type(2)));
typedef float f32x4 __attribute__((ext_vector_type(4)));
typedef float f32x16 __attribute__((ext_vector_type(16)));
typedef unsigned u32x2 __attribute__((ext_vector_type(2)));
typedef unsigned u32x4 __attribute__((ext_vector_type(4)));
typedef __bf16 bf16x2_t __attribute__((ext_vector_type(2)));

__device__ __forceinline__ unsigned cvtpk(float lo, float hi) { f32x2 v = {lo, hi}; bf16x2_t b = __builtin_convertvector(v, bf16x2_t); return __builtin_bit_cast(unsigned, b); }
__device__ __forceinline__ float bf_lo(unsigned w) { return __uint_as_float(w << 16); }
__device__ __forceinline__ float bf_hi(unsigned w) { return __uint_as_float(w & 0xffff0000u); }
__device__ __forceinline__ float fexp2(float x) { return __builtin_amdgcn_exp2f(x); }
__device__ __forceinline__ float flog2(float x) { return __builtin_amdgcn_logf(x); }
__device__ __forceinline__ float frcp(float x) { return __builtin_amdgcn_rcpf(x); }
__device__ __forceinline__ float wave_sum(float v) {
#pragma unroll
    for (int o = 1; o < 64; o <<= 1) v += __shfl_xor(v, o);
    return v;
}
__device__ __forceinline__ int wave_sum_i32(int v) {
    v += __builtin_amdgcn_update_dpp(0, v, 0x111, 0xf, 0xf, false);
    v += __builtin_amdgcn_update_dpp(0, v, 0x112, 0xf, 0xf, false);
    v += __builtin_amdgcn_update_dpp(0, v, 0x114, 0xf, 0xf, false);
    v += __builtin_amdgcn_update_dpp(0, v, 0x118, 0xf, 0xf, false);
    v += __builtin_amdgcn_update_dpp(0, v, 0x142, 0xa, 0xf, false);
    v += __builtin_amdgcn_update_dpp(0, v, 0x143, 0xc, 0xf, false);
    return __builtin_amdgcn_readlane(v, 63);
}
__device__ __forceinline__ unsigned wave_max_u32(unsigned v) {
#define WMX_(ctrl, rm) v = max(v, (unsigned)__builtin_amdgcn_update_dpp(0, (int)v, ctrl, rm, 0xf, false))
    WMX_(0x111, 0xf); WMX_(0x112, 0xf); WMX_(0x114, 0xf); WMX_(0x118, 0xf); WMX_(0x142, 0xa); WMX_(0x143, 0xc);
#undef WMX_
    return (unsigned)__builtin_amdgcn_readlane((int)v, 63);
}
__device__ __forceinline__ unsigned wave_min_u32(unsigned v) {
#define WMN_(ctrl, rm) v = min(v, (unsigned)__builtin_amdgcn_update_dpp(-1, (int)v, ctrl, rm, 0xf, false))
    WMN_(0x111, 0xf); WMN_(0x112, 0xf); WMN_(0x114, 0xf); WMN_(0x118, 0xf); WMN_(0x142, 0xa); WMN_(0x143, 0xc);
#undef WMN_
    return (unsigned)__builtin_amdgcn_readlane((int)v, 63);
}
__device__ __forceinline__ int wave_scan_i32(int v) {
    v += __builtin_amdgcn_update_dpp(0, v, 0x111, 0xf, 0xf, false);
    v += __builtin_amdgcn_update_dpp(0, v, 0x112, 0xf, 0xf, false);
    v += __builtin_amdgcn_update_dpp(0, v, 0x114, 0xf, 0xf, false);
    v += __builtin_amdgcn_update_dpp(0, v, 0x118, 0xf, 0xf, false);
    v += __builtin_amdgcn_update_dpp(0, v, 0x142, 0xa, 0xf, false);
    v += __builtin_amdgcn_update_dpp(0, v, 0x143, 0xc, 0xf, false);
    return v;
}
__device__ __forceinline__ int otid() { int t = threadIdx.x; asm volatile("" : "+v"(t)); return t; }
__device__ __forceinline__ float xhalf(float v) {
    auto rr = __builtin_amdgcn_permlane32_swap(__float_as_uint(v), __float_as_uint(v), false, false);
    return (threadIdx.x & 32) ? __uint_as_float(rr[0]) : __uint_as_float(rr[1]);
}

namespace pg8 {
constexpr int BM = 256, BK = 64, HALF = 128, HTB = HALF * BK * 2, STAGE_BYTES = 8 * HTB, NXCD = 8, WGM = 8;
__host__ __device__ __forceinline__ int lds_byte(int r, int c) { const int st = (r >> 4) * 2 + (c >> 5), rr = r & 15, cc = c & 31, ob = rr * 64 + cc * 2; return st * 1024 + (ob ^ (((ob >> 9) & 1) << 5)); }
__host__ __device__ __forceinline__ void stage_rc(int b, int& R, int& C) { const int st = b / 1024, sb = b % 1024, swz = sb ^ (((sb >> 9) & 1) << 5); R = (st >> 1) * 16 + swz / 64; C = (st & 1) * 32 + (swz % 64) / 2; }
__host__ __device__ __forceinline__ int perm32(int rho) { const int n = rho >> 4, i = rho & 15; return 8 * (i >> 2) + 4 * n + (i & 3); }

struct Unit { int pm, pn, aux; unsigned a, b; int nt; };
struct Gemm { int K, lda, ldb; };

constexpr int UT_OFF = 132096;
struct UnitTab {
    const LAS u32x4* ut;
    __device__ __forceinline__ bool next(int i, Unit& u) const {
        const u32x4 e = ut[i];
        const unsigned w = __builtin_amdgcn_readfirstlane(e.w);
        if (w == 0u) return false;
        u.nt = (int)(w & 0xffffu);
        u.a = __builtin_amdgcn_readfirstlane(e.x); u.b = __builtin_amdgcn_readfirstlane(e.y);
        const unsigned z = __builtin_amdgcn_readfirstlane(e.z); u.pm = z & 4095; u.pn = (z >> 12) & 4095; u.aux = z >> 24; return true;
    }
};
template <class Epi, bool VARK = false, bool ABLK = false>
__device__ __forceinline__ void gemm_phase(LAS unsigned char* lds, const char* base, const Gemm g, const Epi& E) {
    UnitTab S; S.ut = (const LAS u32x4*)(lds + UT_OFF);
    const int tid = otid(), wid = __builtin_amdgcn_readfirstlane(tid >> 6), lane = tid & 63, wr = wid >> 2, wc = wid & 3, fr = lane & 15, fq = lane >> 4;
    const int K = g.K, nt = K / BK;
    unsigned voffA[2], voffB[2];
#pragma unroll
    for (int i = 0; i < 2; ++i) { int R, C; stage_rc(tid * 16 + i * 8192, R, C); const int Rb = 64 * (R >> 5) + (Epi::PERM ? perm32(R & 31) : (R & 31));
        voffA[i] = ABLK ? (unsigned)((C >> 5) * 16384 + R * 64 + (C & 31) * 2) : (unsigned)(R * g.lda + C) * 2u; voffB[i] = (unsigned)(Rb * g.ldb + C) * 2u; }
    const size_t kstep = (size_t)(BK * 2), kstepA = ABLK ? (size_t)32768 : kstep;
    const unsigned hstepA = ABLK ? (unsigned)HALF * 64u : (unsigned)HALF * g.lda * 2, hstepB = 32u * g.ldb * 2;
    const unsigned ldsw = (unsigned)wid * 1024u;
    const int aoff = lds_byte(wr * 64 + fr, fq * 8), boff = lds_byte(wc * 32 + fr, fq * 8);
#define PG8_SA(b, h) (((b) * 2 + (h)) * HTB)
#define PG8_SB(b, h) ((4 + (b) * 2 + (h)) * HTB)
#define PG8_STAGE(bufoff, gbase, voff) do { _Pragma("unroll") for (int _i = 0; _i < 2; ++_i) \
        __builtin_amdgcn_global_load_lds((const unsigned*)((const char*)(gbase) + (voff)[_i]), (LAS unsigned*)(lds + (bufoff) + ldsw + _i * 8192), 16, 0, 0); } while (0)
#define PG8_LDA(dst, b, h) do { _Pragma("unroll") for (int m = 0; m < 4; ++m) _Pragma("unroll") for (int k = 0; k < 2; ++k) dst[m][k] = *(const LAS bf16x8*)(lds + PG8_SA(b, h) + aoff + m * 2048 + k * 1024); } while (0)
#define PG8_LDB(dst, b, h) do { _Pragma("unroll") for (int n = 0; n < 2; ++n) _Pragma("unroll") for (int k = 0; k < 2; ++k) dst[n][k] = *(const LAS bf16x8*)(lds + PG8_SB(b, h) + boff + n * 2048 + k * 1024); } while (0)
#define PG8_MMA(ai, bj, At, Bt) do { __builtin_amdgcn_s_setprio(1); _Pragma("unroll") for (int m = 0; m < 4; ++m) _Pragma("unroll") for (int n = 0; n < 2; ++n) _Pragma("unroll") for (int k = 0; k < 2; ++k) \
        acc[ai][bj][m][n] = __builtin_amdgcn_mfma_f32_16x16x32_bf16(Bt[n][k], At[m][k], acc[ai][bj][m][n], 0, 0, 0); __builtin_amdgcn_s_setprio(0); } while (0)
#define PG8_WAIT_V(n) asm volatile("s_waitcnt vmcnt(" #n ")" ::: "memory")
#define PG8_WAIT_L(n) asm volatile("s_waitcnt lgkmcnt(" #n ")" ::: "memory")
#define PG8_BAR __builtin_amdgcn_s_barrier()
#define PG8_SCHED __builtin_amdgcn_sched_barrier(0)
    Unit cur, nxt; int ui = 0;
    if (!S.next(0, cur)) return;
    f32x4 acc[2][2][4][2];
#pragma unroll
    for (int a = 0; a < 2; ++a)
#pragma unroll
        for (int b = 0; b < 2; ++b)
#pragma unroll
            for (int m = 0; m < 4; ++m)
#pragma unroll
                for (int n = 0; n < 2; ++n) acc[a][b][m][n] = (f32x4){0.f, 0.f, 0.f, 0.f};
    bf16x8 At[4][2], B0[2][2], B1[2][2];
    const char* cA = base + cur.a; const char* cB = base + cur.b;
    PG8_STAGE(PG8_SB(0, 0), cB, voffB); PG8_STAGE(PG8_SB(0, 1), cB + hstepB, voffB); PG8_STAGE(PG8_SA(0, 0), cA, voffA); PG8_STAGE(PG8_SA(0, 1), cA + hstepA, voffA);
    if (wr == 1) PG8_BAR;
    PG8_WAIT_V(2); PG8_BAR;
    PG8_STAGE(PG8_SB(1, 0), cB + kstep, voffB); PG8_STAGE(PG8_SA(1, 0), cA + kstepA, voffA); PG8_STAGE(PG8_SB(1, 1), cB + hstepB + kstep, voffB);
    PG8_WAIT_V(6); PG8_BAR;
    for (;;) {
        const bool has_next = S.next(ui + 1, nxt);
        const char* nA = has_next ? base + nxt.a : cA; const char* nB = has_next ? base + nxt.b : cB;
        const int ntu = VARK ? cur.nt : nt;
        for (int t = 0; t < ntu; t += 2) {
            const bool last = (t == ntu - 2);
            const char* a1 = cA + (size_t)(t + 1) * kstepA;
            const char* a2 = last ? nA : cA + (size_t)(t + 2) * kstepA; const char* b2 = last ? nB : cB + (size_t)(t + 2) * kstep;
            const char* a3 = a2 + kstepA; const char* b3 = b2 + kstep;
            PG8_LDB(B0, 0, 0); PG8_LDB(B1, 0, 1); PG8_SCHED; PG8_LDA(At, 0, 0); PG8_STAGE(PG8_SA(1, 1), a1 + hstepA, voffA);
            PG8_WAIT_V(8); PG8_WAIT_L(0); PG8_BAR; PG8_MMA(0, 0, At, B0); PG8_MMA(0, 1, At, B1); PG8_BAR; PG8_SCHED;
            PG8_LDA(At, 0, 1); PG8_STAGE(PG8_SB(0, 0), b2, voffB); PG8_STAGE(PG8_SB(0, 1), b2 + hstepB, voffB); PG8_STAGE(PG8_SA(0, 0), a2, voffA);
            PG8_WAIT_V(8); PG8_WAIT_L(0); PG8_BAR; PG8_MMA(1, 0, At, B0); PG8_MMA(1, 1, At, B1); PG8_BAR; PG8_SCHED;
            PG8_LDB(B0, 1, 0); PG8_LDB(B1, 1, 1); PG8_SCHED; PG8_LDA(At, 1, 0); PG8_STAGE(PG8_SA(0, 1), a2 + hstepA, voffA);
            PG8_WAIT_V(8); PG8_WAIT_L(0); PG8_BAR; PG8_MMA(0, 0, At, B0); PG8_MMA(0, 1, At, B1); PG8_BAR; PG8_SCHED;
            PG8_LDA(At, 1, 1); PG8_STAGE(PG8_SB(1, 0), b3, voffB); PG8_STAGE(PG8_SB(1, 1), b3 + hstepB, voffB); PG8_STAGE(PG8_SA(1, 0), a3, voffA);
            PG8_WAIT_V(8); PG8_WAIT_L(0); PG8_BAR; PG8_MMA(1, 0, At, B0); PG8_MMA(1, 1, At, B1); PG8_BAR; PG8_SCHED;
        }
        if (wr == 0) PG8_BAR;
        const bool keep = E(acc, cur, wr, wc, fr, fq);
        if (!has_next) break;
        if (!keep) {
#pragma unroll
        for (int a = 0; a < 2; ++a)
#pragma unroll
            for (int b = 0; b < 2; ++b)
#pragma unroll
                for (int m = 0; m < 4; ++m)
#pragma unroll
                    for (int n = 0; n < 2; ++n) acc[a][b][m][n] = (f32x4){0.f, 0.f, 0.f, 0.f};
        }
        cur = nxt; cA = nA; cB = nB; ++ui;
        if (wr == 1) PG8_BAR;
    }
    PG8_WAIT_V(0);
    PG8_BAR;
#undef PG8_SA
#undef PG8_SB
#undef PG8_STAGE
#undef PG8_LDA
#undef PG8_LDB
#undef PG8_MMA
#undef PG8_WAIT_V
#undef PG8_WAIT_L
#undef PG8_BAR
#undef PG8_SCHED
}
}

#define XB_TMO      128
#define XB_XCNT(j)  (256  + 64 * (j))
#define XB_XSUB(j)  (1280 + 64 * (j))
#define XB_XGEN(j)  (2304 + 64 * (j))
#define XB_TOP      3328
#define XB_TOPGEN   3392
#define XCD_BAR_WORDS 3456
#define XB_SPIN_CAP (1u << 18)
__device__ __forceinline__ unsigned xb_ld(unsigned* p)              { return __hip_atomic_load(p, __ATOMIC_RELAXED, __HIP_MEMORY_SCOPE_AGENT); }
__device__ __forceinline__ unsigned xb_add(unsigned* p, unsigned v) { asm volatile("" : "+v"(v)); return __hip_atomic_fetch_add(p, v, __ATOMIC_RELAXED, __HIP_MEMORY_SCOPE_AGENT); }
__device__ __forceinline__ unsigned xb_xcc_id() { return (unsigned)__builtin_amdgcn_s_getreg((3 << 11) | 20) & 0xFu; }
#define XB_SPIN(cond, bar) do { unsigned _sp = 0; while (cond) { __builtin_amdgcn_s_sleep(1); \
    if ((++_sp & 255u) == 0u) { if (xb_ld(&(bar)[XB_TMO])) break; if (_sp > XB_SPIN_CAP) { (void)xb_add(&(bar)[XB_TMO], 1u); break; } } } } while (0)
struct XcdBarrier { unsigned* bar; unsigned x; volatile LAS unsigned* st; };
__device__ __forceinline__ XcdBarrier xcd_barrier_post(unsigned* bar, volatile LAS unsigned* st) {
    XcdBarrier b; b.bar = bar; b.x = xb_xcc_id(); b.st = st;
    if (threadIdx.x == 0) (void)xb_add(&bar[XB_XCNT(b.x)], 1u);
    return b;
}
__device__ __forceinline__ void xcd_barrier_complete(unsigned* bar, unsigned x, unsigned& nloc, unsigned& nx) {
    const unsigned G = gridDim.x * gridDim.y * gridDim.z;
    unsigned sum, cnt, mine, sp = 0u;
    for (;;) {
        sum = 0u; cnt = 0u; mine = 0u;
#pragma unroll 1
        for (unsigned j = 0; j < 16; ++j) { const unsigned c = xb_ld(&bar[XB_XCNT(j)]); sum += c; cnt += (c > 0u) ? 1u : 0u; mine = (j == x) ? c : mine; }
        if (sum == G) break;
        __builtin_amdgcn_s_sleep(1);
        if ((++sp & 255u) == 0u) { if (xb_ld(&bar[XB_TMO])) break; if (sp > XB_SPIN_CAP) { (void)xb_add(&bar[XB_TMO], 1u); break; } }
    }
    nloc = mine > 0u ? mine : 1u; nx = cnt > 0u ? cnt : 1u;
}
__device__ __forceinline__ void xcd_barrier(const XcdBarrier& b) {
    asm volatile("s_waitcnt vmcnt(0)" ::: "memory");
    __syncthreads();
    if (threadIdx.x == 0) {
        unsigned* bar = b.bar; asm volatile("" : "+s"(bar));
        __builtin_amdgcn_s_waitcnt(0);
        unsigned nloc = b.st[0], nx = b.st[1];
        if (nloc == 0u) { xcd_barrier_complete(bar, b.x, nloc, nx); b.st[0] = nloc; b.st[1] = nx; }
        const unsigned old = xb_add(&bar[XB_XSUB(b.x)], 1u);
        const unsigned gen = old / nloc;
        if (old + 1u == (gen + 1u) * nloc) {
            __builtin_amdgcn_fence(__ATOMIC_RELEASE, "agent");
            asm volatile("s_waitcnt vmcnt(0)" ::: "memory");
            const unsigned og = xb_add(&bar[XB_TOP], 1u);
            const unsigned tg = og / nx;
            if (og + 1u == (tg + 1u) * nx) xb_add(&bar[XB_TOPGEN], 1u);
            else XB_SPIN(xb_ld(&bar[XB_TOPGEN]) == tg, bar);
            __builtin_amdgcn_fence(__ATOMIC_ACQUIRE, "agent");
            xb_add(&bar[XB_XGEN(b.x)], 1u);
            asm volatile("s_waitcnt vmcnt(0)" ::: "memory");
        } else {
            XB_SPIN(xb_ld(&bar[XB_XGEN(b.x)]) == gen, bar);
            __builtin_amdgcn_fence(__ATOMIC_ACQUIRE, "agent");
            asm volatile("s_waitcnt vmcnt(0)" ::: "memory");
        }
    }
    __syncthreads();
}

constexpr int BATCH = 4, SEQ = 4096, T = BATCH * SEQ, D = 1024, DEPTH = 2;
constexpr int NPROJ = 6656;
constexpr int NP = 6784;
constexpr int VTP = T + 128;
constexpr int C_QA = 0, C_KA = 512, C_QB = 1024, C_KB = 1536, C_QC = 2048, C_KC = 2560, C_GATE = 3072, C_QI = 6144, C_KI = 6400, C_WI = 6464;
constexpr int DFF = 2816, DFFE = 3584, NE = 8;
constexpr int XP_ROWS = 2 * T + 2048;
constexpr float LOG2E = 1.4426950408889634f;
constexpr float C2 = 0.125f * LOG2E;
constexpr int NWAVES = 8, NTHREADS = 512;

constexpr size_t MiB = 1u << 20;
constexpr size_t WS_CTL = 0, CTL_ZERO_BYTES = 64 * 1024;
constexpr size_t WS_MOD = 1 * MiB;
constexpr size_t WS_RTE = 1 * MiB + 256 * 1024;
constexpr size_t WS_RTW = WS_RTE + 64 * 1024;
constexpr size_t WS_POS = WS_RTW + 128 * 1024;
constexpr size_t WS_WGCNT = WS_POS + 128 * 1024;
constexpr size_t WS_TILETAB = WS_WGCNT + 8 * 1024;
constexpr size_t WS_MW13 = 3 * MiB, WS_MW2 = 115 * MiB;
constexpr size_t WS_WIN = 171 * MiB, WS_WV = WS_WIN + 26 * MiB, WS_WBR = WS_WV + 6 * MiB, WS_WOUT = WS_WBR + 6 * MiB, WS_W13 = WS_WOUT + 4 * MiB, WS_W2 = WS_W13 + 11 * MiB;
constexpr size_t WS_OC = WS_W2 + 6 * MiB;
constexpr size_t WS_MASK = WS_OC + 16 * MiB;
constexpr size_t WS_WI = WS_MASK + 8 * MiB;
constexpr size_t WS_XP = WS_WIN;
constexpr size_t WS_XN = 256 * MiB;
constexpr size_t WS_OA = WS_XN, WS_OB = WS_XN + 16 * MiB;
constexpr size_t WS_PROJ = 288 * MiB;
constexpr size_t WS_VT = WS_PROJ + 212 * MiB;
constexpr size_t WS_MERGED = WS_VT;
constexpr size_t WS_HID = WS_PROJ;
constexpr size_t WS_END = WS_VT + 49 * MiB;
static_assert(WS_WI + 256 * 1024 <= WS_XN && WS_XP + (size_t)XP_ROWS * 2048 <= WS_XN, "ws map");
static_assert(WS_HID + (size_t)XP_ROWS * DFFE * 2 <= WS_END && WS_PROJ + (size_t)T * NP * 2 <= WS_VT && WS_VT + (size_t)1536 * VTP * 2 <= WS_END, "ws map hid");
constexpr int CW_TMO = 0, CW_BAR = 1024;

struct Seg { int in_idx; long long src_off; int ldw, K, ncols; unsigned long long dst; int row0, blk, stride, item0; };
constexpr int NSEG = 61, SEG_ITEMS = 28928;
__device__ const Seg g_segs[NSEG] = {
{6, 0, 8004, 1024, 512, 179306496ull, 0, 1073741824, 0, 0},
{6, 512, 8004, 1024, 512, 179306496ull, 512, 1073741824, 0, 128},
{6, 1024, 8004, 1024, 512, 206569472ull, 0, 1073741824, 0, 256},
{6, 1536, 8004, 1024, 256, 179306496ull, 6144, 1073741824, 0, 384},
{6, 1792, 8004, 1024, 64, 179306496ull, 6400, 1073741824, 0, 448},
{6, 1856, 8004, 1024, 4, 179306496ull, 6464, 1073741824, 0, 464},
{6, 1860, 8004, 1024, 512, 179306496ull, 1024, 1073741824, 0, 480},
{6, 2372, 8004, 1024, 512, 179306496ull, 1536, 1073741824, 0, 608},
{6, 2884, 8004, 1024, 512, 206569472ull, 512, 1073741824, 0, 736},
{6, 3396, 8004, 1024, 512, 179306496ull, 2048, 1073741824, 0, 864},
{6, 3908, 8004, 1024, 512, 179306496ull, 2560, 1073741824, 0, 992},
{6, 4420, 8004, 1024, 512, 206569472ull, 1024, 1073741824, 0, 1120},
{6, 4932, 8004, 1024, 3072, 179306496ull, 3072, 1073741824, 0, 1248},
{7, 0, 1024, 512, 1024, 212860928ull, 0, 1073741824, 0, 2016},
{7, 524288, 1024, 512, 1024, 213909504ull, 0, 1073741824, 0, 2144},
{7, 1048576, 1024, 512, 1024, 214958080ull, 0, 1073741824, 0, 2272},
{8, 0, 1024, 1024, 1024, 219152384ull, 0, 1073741824, 0, 2400},
{6, 8196096, 8004, 1024, 512, 192937984ull, 0, 1073741824, 0, 2656},
{6, 8196608, 8004, 1024, 512, 192937984ull, 512, 1073741824, 0, 2784},
{6, 8197120, 8004, 1024, 512, 209715200ull, 0, 1073741824, 0, 2912},
{6, 8197632, 8004, 1024, 256, 192937984ull, 6144, 1073741824, 0, 3040},
{6, 8197888, 8004, 1024, 64, 192937984ull, 6400, 1073741824, 0, 3104},
{6, 8197952, 8004, 1024, 4, 192937984ull, 6464, 1073741824, 0, 3120},
{6, 8197956, 8004, 1024, 512, 192937984ull, 1024, 1073741824, 0, 3136},
{6, 8198468, 8004, 1024, 512, 192937984ull, 1536, 1073741824, 0, 3264},
{6, 8198980, 8004, 1024, 512, 209715200ull, 512, 1073741824, 0, 3392},
{6, 8199492, 8004, 1024, 512, 192937984ull, 2048, 1073741824, 0, 3520},
{6, 8200004, 8004, 1024, 512, 192937984ull, 2560, 1073741824, 0, 3648},
{6, 8200516, 8004, 1024, 512, 209715200ull, 1024, 1073741824, 0, 3776},
{6, 8201028, 8004, 1024, 3072, 192937984ull, 3072, 1073741824, 0, 3904},
{7, 1572864, 1024, 512, 1024, 216006656ull, 0, 1073741824, 0, 4672},
{7, 2097152, 1024, 512, 1024, 217055232ull, 0, 1073741824, 0, 4800},
{7, 2621440, 1024, 512, 1024, 218103808ull, 0, 1073741824, 0, 4928},
{8, 1048576, 1024, 1024, 1024, 221249536ull, 0, 1073741824, 0, 5056},
{12, 0, 2816, 1024, 2816, 223346688ull, 0, 32, 64, 5312},
{13, 0, 2816, 1024, 2816, 223346688ull, 32, 32, 64, 6016},
{14, 0, 1024, 2816, 1024, 234881024ull, 0, 1073741824, 0, 6720},
{17, 0, 3584, 1024, 3584, 3145728ull, 0, 32, 64, 7424},
{18, 0, 3584, 1024, 3584, 3145728ull, 32, 32, 64, 8320},
{19, 0, 1024, 3584, 1024, 120586240ull, 0, 1073741824, 0, 9216},
{17, 3670016, 3584, 1024, 3584, 17825792ull, 0, 32, 64, 10112},
{18, 3670016, 3584, 1024, 3584, 17825792ull, 32, 32, 64, 11008},
{19, 3670016, 1024, 3584, 1024, 127926272ull, 0, 1073741824, 0, 11904},
{17, 7340032, 3584, 1024, 3584, 32505856ull, 0, 32, 64, 12800},
{18, 7340032, 3584, 1024, 3584, 32505856ull, 32, 32, 64, 13696},
{19, 7340032, 1024, 3584, 1024, 135266304ull, 0, 1073741824, 0, 14592},
{17, 11010048, 3584, 1024, 3584, 47185920ull, 0, 32, 64, 15488},
{18, 11010048, 3584, 1024, 3584, 47185920ull, 32, 32, 64, 16384},
{19, 11010048, 1024, 3584, 1024, 142606336ull, 0, 1073741824, 0, 17280},
{17, 14680064, 3584, 1024, 3584, 61865984ull, 0, 32, 64, 18176},
{18, 14680064, 3584, 1024, 3584, 61865984ull, 32, 32, 64, 19072},
{19, 14680064, 1024, 3584, 1024, 149946368ull, 0, 1073741824, 0, 19968},
{17, 18350080, 3584, 1024, 3584, 76546048ull, 0, 32, 64, 20864},
{18, 18350080, 3584, 1024, 3584, 76546048ull, 32, 32, 64, 21760},
{19, 18350080, 1024, 3584, 1024, 157286400ull, 0, 1073741824, 0, 22656},
{17, 22020096, 3584, 1024, 3584, 91226112ull, 0, 32, 64, 23552},
{18, 22020096, 3584, 1024, 3584, 91226112ull, 32, 32, 64, 24448},
{19, 22020096, 1024, 3584, 1024, 164626432ull, 0, 1073741824, 0, 25344},
{17, 25690112, 3584, 1024, 3584, 105906176ull, 0, 32, 64, 26240},
{18, 25690112, 3584, 1024, 3584, 105906176ull, 32, 32, 64, 27136},
{19, 25690112, 1024, 3584, 1024, 171966464ull, 0, 1073741824, 0, 28032}
};

struct Args { const float* in[21]; float* out; unsigned char* ws; int ph_lo, ph_hi; };
__device__ __forceinline__ const float* karg_in(int i) {
    const __attribute__((address_space(4))) unsigned long long* p = (const __attribute__((address_space(4))) unsigned long long*)__builtin_amdgcn_kernarg_segment_ptr();
    int j = i; asm volatile("" : "+s"(j));
    return (const float*)p[j];
}
__device__ __forceinline__ int karg_int(int word) {
    const __attribute__((address_space(4))) int* p = (const __attribute__((address_space(4))) int*)__builtin_amdgcn_kernarg_segment_ptr();
    int j = word; asm volatile("" : "+s"(j));
    return p[j];
}
__device__ __forceinline__ unsigned char* wsp(unsigned char* ws, unsigned long long off) { asm volatile("" : "+s"(off)); return ws + off; }


struct TileSched {
    unsigned A, B, astep, bstep; int nM, nN, nwg, G, c, ord;
    __device__ void init(size_t A_, size_t B_, int M, int N, int lda, int ldb, int G_, int c_) {
        A = (unsigned)A_; B = (unsigned)B_; astep = 256u * lda * 2; bstep = 256u * ldb * 2; nM = M / 256; nN = N / 256; nwg = nM * nN; G = G_; c = c_; ord = 0; }
    __device__ bool next(int i, pg8::Unit& u) const {
        const int L = i * G + c; if (L >= nwg) return false;
#ifndef XCD_ORDER
        if (ord == 2 || (ord == 0 && nM == 64)) {
             u.pm = L / nN; u.pn = L - u.pm * nN; u.aux = 0; u.a = A + (unsigned)u.pm * astep; u.b = B + (unsigned)u.pn * bstep; return true; }
#endif
        int wgid = L; { const int q = nwg / pg8::NXCD, r = nwg % pg8::NXCD, xcd = wgid % pg8::NXCD, off = wgid / pg8::NXCD; wgid = (xcd < r ? xcd * (q + 1) : r * (q + 1) + (xcd - r) * q) + off; }
        const int nig = pg8::WGM * nN, gid = wgid / nig, fm = gid * pg8::WGM, gsz = (nM - fm) < pg8::WGM ? (nM - fm) : pg8::WGM;
        u.pm = fm + ((wgid % nig) % gsz); u.pn = (wgid % nig) / gsz; u.aux = 0; u.a = A + (unsigned)u.pm * astep; u.b = B + (unsigned)u.pn * bstep; return true;
    }
};
struct BranchSched {
    unsigned B; int c;
    __device__ bool next(int i, pg8::Unit& u) const {
        if (i >= 3 || c >= 256) return false;
        u.pm = c >> 2; u.pn = c & 3; u.aux = i;
        const unsigned Ab = (i == 0) ? (unsigned)WS_OA : (i == 1 ? (unsigned)WS_OB : (unsigned)WS_OC);
        u.a = Ab + (unsigned)u.pm * (256u * 512 * 2); u.b = B + (unsigned)i * (unsigned)MiB + (unsigned)u.pn * (256u * 512 * 2); return true;
    }
};
struct MoeSched {
    unsigned A, B; const int* tab; unsigned astep, bstep, estep; int nN, G, c; int ks; unsigned kbytes, kbytesA;
    __device__ bool next(int i, pg8::Unit& u) const {
        const int nt = tab[0];
#ifdef MOE_XCD
        if (ks == 1 && G == 256 && nN == 16) {
            const int x = c & 7, j = c >> 3;
            u.pm = i * 16 + (x >> 2) * 8 + (j >> 2); u.pn = (x & 3) * 4 + (j & 3); u.aux = 0;
            if (u.pm >= nt) return false;
            const int e = tab[1 + u.pm];
            u.a = A + (unsigned)u.pm * astep; u.b = B + (unsigned)e * estep + (unsigned)u.pn * bstep; return true;
        }
#endif
#if defined(MOE_XCD) && MOE_XCD == 2
        if (ks == 1 && G == 256) {
            const int tot = nt * nN, q = (tot + 7) >> 3, x = c & 7, j = c >> 3, li = i * 32 + j;
            if (li >= q) return false;
            const int idx = x * q + li; if (idx >= tot) return false;
            const int nig = 8 * nN, gid = idx / nig, fm = gid * 8, gsz = (nt - fm) < 8 ? (nt - fm) : 8, w = idx - gid * nig;
            u.pn = w / gsz; u.pm = fm + (w - u.pn * gsz); u.aux = 0;
            const int e = tab[1 + u.pm];
            u.a = A + (unsigned)u.pm * astep; u.b = B + (unsigned)e * estep + (unsigned)u.pn * bstep; return true;
        }
#endif
        const int L = i * G + c; if (L >= nt * nN * ks) return false;
        const int L2 = L / ks; u.aux = L - L2 * ks;
        u.pm = L2 / nN; u.pn = L2 - u.pm * nN;
        const int e = tab[1 + u.pm];
        u.a = A + (unsigned)u.pm * astep + (unsigned)u.aux * kbytesA; u.b = B + (unsigned)e * estep + (unsigned)u.pn * bstep + (unsigned)u.aux * kbytes; return true;
    }
};

template <class Sched>
__device__ __forceinline__ void fill_units(LAS unsigned char* lds, const Sched& S) {
    LAS u32x4* ut = (LAS u32x4*)(lds + pg8::UT_OFF);
    const int tid = otid();
    if (tid < 64) { pg8::Unit u; u.nt = 0; u32x4 e = {0u, 0u, 0u, 0u};
        if (S.next(tid, u)) { e.x = u.a; e.y = u.b; e.z = (unsigned)u.pm | ((unsigned)u.pn << 12) | ((unsigned)u.aux << 24); e.w = 0x10000u | (unsigned)u.nt; }
        ut[tid] = e; }
    __syncthreads();
}

#ifdef EPI_NT
#define EPI_ST16(p, v) __builtin_nontemporal_store((v), (p))
#else
#define EPI_ST16(p, v) (*(p) = (v))
constexpr int EPI_SCR_OFF = 133120, EPI_SCR_WAVE = 2304;
__device__ __forceinline__ void epi_store_16x64(LAS unsigned char* scr, bf16_t* tile  , size_t pitch, int fr, int fq, const u32x4& w0, const u32x4& w1) {
    *(LAS u32x4*)(scr + fr * 144 + fq * 16) = w0; *(LAS u32x4*)(scr + fr * 144 + 64 + fq * 16) = w1;
    const int lane = fr + 16 * fq, r8 = lane >> 3, ch = lane & 7;
    const u32x4 a = *(const LAS u32x4*)(scr + r8 * 144 + ch * 16), b = *(const LAS u32x4*)(scr + (r8 + 8) * 144 + ch * 16);
#ifdef EPI_WT
    asm volatile("global_store_dwordx4 %0, %1, off sc1\n\ts_nop 1" :: "v"(tile + (size_t)r8 * pitch + ch * 8), "v"(a) : "memory");
    asm volatile("global_store_dwordx4 %0, %1, off sc1\n\ts_nop 1" :: "v"(tile + (size_t)(r8 + 8) * pitch + ch * 8), "v"(b) : "memory");
#else
    *(GAS u32x4*)(tile + (size_t)r8 * pitch + ch * 8) = a; *(GAS u32x4*)(tile + (size_t)(r8 + 8) * pitch + ch * 8) = b;
#endif
}
#endif
__device__ __forceinline__ float sigmoidf_(float v) { return frcp(1.f + fexp2(-v * LOG2E)); }
struct EpiProj {
    static constexpr bool PERM = true;
    bf16_t* O; float* WI; LAS unsigned char* lds;
    __device__ __forceinline__ bool operator()(const f32x4 (&acc)[2][2][4][2], const pg8::Unit& u, int wr, int wc, int fr, int fq) const {
        const int pn = u.pn; const bool gate = (pn >= 12 && pn < 24);
        const float sc = (pn < 2 || pn == 4 || pn == 5 || pn == 8 || pn == 9) ? C2 : (pn == 24 ? 0.125f : 1.f);
        const int row0 = u.pm * 256 + wr * 64 + fr;
        LAS unsigned char* scr = lds + EPI_SCR_OFF + (wr * 4 + wc) * EPI_SCR_WAVE;
#pragma unroll
        for (int ai = 0; ai < 2; ++ai)
#pragma unroll
            for (int m = 0; m < 4; ++m) { u32x4 w[2];
#pragma unroll
                for (int bj = 0; bj < 2; ++bj) { f32x4 v0 = acc[ai][bj][m][0], v1 = acc[ai][bj][m][1];
                    if (gate) {
#pragma unroll
                        for (int k = 0; k < 4; ++k) { v0[k] = sigmoidf_(v0[k]); v1[k] = sigmoidf_(v1[k]); }
                    } else { v0 = v0 * sc; v1 = v1 * sc; }
                    w[bj].x = cvtpk(v0[0], v0[1]); w[bj].y = cvtpk(v0[2], v0[3]); w[bj].z = cvtpk(v1[0], v1[1]); w[bj].w = cvtpk(v1[2], v1[3]); }
                epi_store_16x64(scr, O + (size_t)(u.pm * 256 + wr * 64 + ai * 128 + m * 16) * NP + pn * 256 + wc * 64, NP, fr, fq, w[0], w[1]); }
        if (pn == 25 && wc == 1 && fq == 0) {
#pragma unroll
            for (int ai = 0; ai < 2; ++ai)
#pragma unroll
                for (int m = 0; m < 4; ++m) *(GAS f32x4*)(WI + (size_t)(row0 + ai * 128 + m * 16) * 4) = acc[ai][0][m][0] * 0.5f;
        }
        return false;
    }
};
struct EpiNone {
    static constexpr bool PERM = true;
    bf16_t* O;
    __device__ __forceinline__ bool operator()(const f32x4 (&acc)[2][2][4][2], const pg8::Unit& u, int wr, int wc, int fr, int fq) const {
        float s = 0.f;
#pragma unroll
        for (int ai = 0; ai < 2; ++ai)
#pragma unroll
            for (int bj = 0; bj < 2; ++bj)
#pragma unroll
                for (int m = 0; m < 4; ++m)
#pragma unroll
                    for (int n = 0; n < 2; ++n) s += acc[ai][bj][m][n][0] + acc[ai][bj][m][n][1] + acc[ai][bj][m][n][2] + acc[ai][bj][m][n][3];
        if (s == 1.2345e30f) O[0] = 1;
        return false;
    }
};
struct EpiQuarter {
    static constexpr bool PERM = true;
    bf16_t* O; int ldc;
    __device__ __forceinline__ bool operator()(const f32x4 (&acc)[2][2][4][2], const pg8::Unit& u, int wr, int wc, int fr, int fq) const {
        const int row0 = u.pm * 256 + wr * 64 + fr, col0 = u.pn * 256 + wc * 64 + 8 * fq;
        float s = 0.f;
#pragma unroll
        for (int ai = 0; ai < 2; ++ai)
#pragma unroll
            for (int m = 0; m < 4; ++m) { bf16_t* rowp = O + (size_t)(row0 + ai * 128 + m * 16) * ldc + col0;
#pragma unroll
                for (int bj = 0; bj < 2; ++bj) { const f32x4 v0 = acc[ai][bj][m][0], v1 = acc[ai][bj][m][1];
                    u32x4 w; w.x = cvtpk(v0[0], v0[1]); w.y = cvtpk(v0[2], v0[3]); w.z = cvtpk(v1[0], v1[1]); w.w = cvtpk(v1[2], v1[3]);
                    if (m == 0 && ai == 0) EPI_ST16((GAS u32x4*)(rowp + bj * 32), w); else s += __uint_as_float(w.x ^ w.y ^ w.z ^ w.w); } }
        if (s == 1.2345e30f) O[0] = 1;
        return false;
    }
};
struct EpiBlocked {
    static constexpr bool PERM = true;
    bf16_t* O;
    __device__ __forceinline__ bool operator()(const f32x4 (&acc)[2][2][4][2], const pg8::Unit& u, int wr, int wc, int fr, int fq) const {
        const int row0 = u.pm * 256 + wr * 64 + fr, col0 = wc * 64 + 8 * fq;
#pragma unroll
        for (int ai = 0; ai < 2; ++ai)
#pragma unroll
            for (int m = 0; m < 4; ++m) { bf16_t* rowp = O + (size_t)u.pn * ((size_t)T * 256) + (size_t)(row0 + ai * 128 + m * 16) * 256 + col0;
#pragma unroll
                for (int bj = 0; bj < 2; ++bj) { const f32x4 v0 = acc[ai][bj][m][0], v1 = acc[ai][bj][m][1];
                    u32x4 w; w.x = cvtpk(v0[0], v0[1]); w.y = cvtpk(v0[2], v0[3]); w.z = cvtpk(v1[0], v1[1]); w.w = cvtpk(v1[2], v1[3]);
                    *(GAS u32x4*)(rowp + bj * 32) = w; } }
        return false;
    }
};
struct EpiLinear {
    static constexpr bool PERM = true;
    bf16_t* O;
    __device__ __forceinline__ bool operator()(const f32x4 (&acc)[2][2][4][2], const pg8::Unit& u, int wr, int wc, int fr, int fq) const {
        const int lane = fr + 16 * fq, wv = wr * 4 + wc;
        bf16_t* base = O + ((size_t)(u.pm * 26 + u.pn) * 65536) + (size_t)wv * 8192 + lane * 8;
#pragma unroll
        for (int ai = 0; ai < 2; ++ai)
#pragma unroll
            for (int m = 0; m < 4; ++m)
#pragma unroll
                for (int bj = 0; bj < 2; ++bj) { const f32x4 v0 = acc[ai][bj][m][0], v1 = acc[ai][bj][m][1];
                    u32x4 w; w.x = cvtpk(v0[0], v0[1]); w.y = cvtpk(v0[2], v0[3]); w.z = cvtpk(v1[0], v1[1]); w.w = cvtpk(v1[2], v1[3]);
                    *(GAS u32x4*)(base + ((ai * 4 + m) * 2 + bj) * 512) = w; }
        return false;
    }
};
struct EpiBf16 {
    static constexpr bool PERM = true;
    bf16_t* O; int ldc; LAS unsigned char* lds;
    __device__ __forceinline__ bool operator()(const f32x4 (&acc)[2][2][4][2], const pg8::Unit& u, int wr, int wc, int fr, int fq) const {
        LAS unsigned char* scr = lds + EPI_SCR_OFF + (wr * 4 + wc) * EPI_SCR_WAVE;
#pragma unroll
        for (int ai = 0; ai < 2; ++ai)
#pragma unroll
            for (int m = 0; m < 4; ++m) { u32x4 w[2];
#pragma unroll
                for (int bj = 0; bj < 2; ++bj) { const f32x4 v0 = acc[ai][bj][m][0], v1 = acc[ai][bj][m][1];
                    w[bj].x = cvtpk(v0[0], v0[1]); w[bj].y = cvtpk(v0[2], v0[3]); w[bj].z = cvtpk(v1[0], v1[1]); w[bj].w = cvtpk(v1[2], v1[3]); }
                epi_store_16x64(scr, O + (size_t)(u.pm * 256 + wr * 64 + ai * 128 + m * 16) * ldc + u.pn * 256 + wc * 64, (size_t)ldc, fr, fq, w[0], w[1]); }
        return false;
    }
};
struct EpiBf16Split {
    static constexpr bool PERM = true;
    bf16_t* O0; bf16_t* O1; int ldc; LAS unsigned char* lds;
    __device__ __forceinline__ bool operator()(const f32x4 (&acc)[2][2][4][2], const pg8::Unit& u, int wr, int wc, int fr, int fq) const {
        bf16_t* O = u.aux ? O1 : O0;
        LAS unsigned char* scr = lds + EPI_SCR_OFF + (wr * 4 + wc) * EPI_SCR_WAVE;
#pragma unroll
        for (int ai = 0; ai < 2; ++ai)
#pragma unroll
            for (int m = 0; m < 4; ++m) { u32x4 w[2];
#pragma unroll
                for (int bj = 0; bj < 2; ++bj) { const f32x4 v0 = acc[ai][bj][m][0], v1 = acc[ai][bj][m][1];
                    w[bj].x = cvtpk(v0[0], v0[1]); w[bj].y = cvtpk(v0[2], v0[3]); w[bj].z = cvtpk(v1[0], v1[1]); w[bj].w = cvtpk(v1[2], v1[3]); }
                epi_store_16x64(scr, O + (size_t)(u.pm * 256 + wr * 64 + ai * 128 + m * 16) * ldc + u.pn * 256 + wc * 64, (size_t)ldc, fr, fq, w[0], w[1]); }
        return false;
    }
};
struct EpiBranch {
    static constexpr bool PERM = true;
    const bf16_t* G; bf16_t* O; LAS unsigned char* lds;
    static __device__ __forceinline__ float rat(float a, float b) { return a * frcp(fmaxf(b, 1e-30f)); }
    __device__ __forceinline__ bool operator()(f32x4 (&acc)[2][2][4][2], const pg8::Unit& u, int wr, int wc, int fr, int fq) const {
        const int sub = u.aux;
        const int row0 = u.pm * 256 + wr * 64 + fr, col0 = u.pn * 256 + wc * 64 + 8 * fq;
        LAS unsigned char* scr = lds + EPI_SCR_OFF + (wr * 4 + wc) * EPI_SCR_WAVE;
#pragma unroll
        for (int ai = 0; ai < 2; ++ai)
#pragma unroll
            for (int m = 0; m < 4; ++m) { const unsigned r = (unsigned)(row0 + ai * 128 + m * 16); u32x4 w[2];
#pragma unroll
                for (int bj = 0; bj < 2; ++bj) {
                    const bf16_t* gp = G + (size_t)r * NP + col0 + bj * 32;
                    const u32x4 gx = *(const GAS u32x4*)(gp + sub * 1024);
                    f32x4 f0 = {bf_lo(gx.x), bf_hi(gx.x), bf_lo(gx.y), bf_hi(gx.y)}, f1 = {bf_lo(gx.z), bf_hi(gx.z), bf_lo(gx.w), bf_hi(gx.w)};
                    if (sub < 2) { const u32x4 gy = *(const GAS u32x4*)(gp + (sub + 1) * 1024);
                        f0 = (f32x4){rat(f0.x, bf_lo(gy.x)), rat(f0.y, bf_hi(gy.x)), rat(f0.z, bf_lo(gy.y)), rat(f0.w, bf_hi(gy.y))};
                        f1 = (f32x4){rat(f1.x, bf_lo(gy.z)), rat(f1.y, bf_hi(gy.z)), rat(f1.z, bf_lo(gy.w)), rat(f1.w, bf_hi(gy.w))}; }
                    const f32x4 v0 = acc[ai][bj][m][0] * f0, v1 = acc[ai][bj][m][1] * f1;
                    acc[ai][bj][m][0] = v0; acc[ai][bj][m][1] = v1;
                    w[bj].x = cvtpk(v0[0], v0[1]); w[bj].y = cvtpk(v0[2], v0[3]); w[bj].z = cvtpk(v1[0], v1[1]); w[bj].w = cvtpk(v1[2], v1[3]); }
                if (sub == 2) epi_store_16x64(scr, O + (size_t)(u.pm * 256 + wr * 64 + ai * 128 + m * 16) * 1024 + u.pn * 256 + wc * 64, 1024, fr, fq, w[0], w[1]); }
        return sub < 2;
    }
};
struct EpiResid {
    static constexpr bool PERM = false;
    const float* xin; float* xout; const float* gate; LAS unsigned char* lds;
    __device__ __forceinline__ bool operator()(const f32x4 (&acc)[2][2][4][2], const pg8::Unit& u, int wr, int wc, int fr, int fq) const {
        const int row0 = u.pm * 256 + wr * 64 + fr, col0 = u.pn * 256 + wc * 64 + 4 * fq;
        const float* gp = gate + (size_t)(u.pm >> 4) * 6144 + col0;
        LAS unsigned char* scr = lds + EPI_SCR_OFF + (wr * 4 + wc) * EPI_SCR_WAVE;
        f32x4 gv[2][2];
#pragma unroll
        for (int bj = 0; bj < 2; ++bj)
#pragma unroll
            for (int n = 0; n < 2; ++n) gv[bj][n] = *(const GAS f32x4*)(gp + bj * 32 + n * 16);
#pragma unroll
        for (int am = 0; am < 8; am += 2) {
            f32x4 xv[2][2][2];
#pragma unroll
            for (int q = 0; q < 2; ++q) { const int ai = (am + q) >> 2, m = (am + q) & 3; const size_t off = (size_t)(row0 + ai * 128 + m * 16) * D + col0;
#pragma unroll
                for (int bj = 0; bj < 2; ++bj)
#pragma unroll
                    for (int n = 0; n < 2; ++n) xv[q][bj][n] = *(const GAS f32x4*)(xin + off + bj * 32 + n * 16); }
#pragma unroll
            for (int q = 0; q < 2; ++q) { const int ai = (am + q) >> 2, m = (am + q) & 3; const size_t off = (size_t)(row0 + ai * 128 + m * 16) * D + col0;
#pragma unroll
                for (int bj = 0; bj < 2; ++bj)
                    { const f32x4 r0 = xv[q][bj][0] + gv[bj][0] * acc[ai][bj][m][0], r1 = xv[q][bj][1] + gv[bj][1] * acc[ai][bj][m][1]; (void)off;
                      epi_store_16x64(scr, (bf16_t*)(xout + (size_t)(u.pm * 256 + wr * 64 + ai * 128 + m * 16) * D + u.pn * 256 + wc * 64 + bj * 32), 2 * (size_t)D, fr, fq, __builtin_bit_cast(u32x4, r0), __builtin_bit_cast(u32x4, r1)); } }
        }
        return false;
    }
};
struct EpiSwiGLU {
    static constexpr bool PERM = true;
    bf16_t* O; int ldc;
    __device__ __forceinline__ bool operator()(const f32x4 (&acc)[2][2][4][2], const pg8::Unit& u, int wr, int wc, int fr, int fq) const {
        bf16_t* ob = O + (size_t)u.pm * 256 * ldc + (size_t)(u.pn * 4 + wc) * 8192 + (wr * 64 + fr) * 32 + 8 * fq;
#pragma unroll
        for (int ai = 0; ai < 2; ++ai)
#pragma unroll
            for (int m = 0; m < 4; ++m) { float h[8];
#pragma unroll
                for (int n = 0; n < 2; ++n)
#pragma unroll
                    for (int k = 0; k < 4; ++k) { const float a = acc[ai][0][m][n][k], b = acc[ai][1][m][n][k]; h[n * 4 + k] = a * sigmoidf_(a) * b; }
                u32x4 w; w.x = cvtpk(h[0], h[1]); w.y = cvtpk(h[2], h[3]); w.z = cvtpk(h[4], h[5]); w.w = cvtpk(h[6], h[7]);
                EPI_ST16((GAS u32x4*)(ob + (ai * 128 + m * 16) * 32), w); }
        return false;
    }
};

struct Frame {
    LAS unsigned char* lds;
    int G, vcu, bx;
    unsigned char* ws;
};
#define THREAD_IDS() const int tid = otid(), lane = tid & 63, wave = __builtin_amdgcn_readfirstlane(tid >> 6); (void)lane; (void)wave
#define LDS_WAIT() asm volatile("s_waitcnt lgkmcnt(0)" ::: "memory")

__device__ __forceinline__ void transpose_item(const GAS float* W, const Seg& s, GAS unsigned char* ws, LAS float* scr, int item, int lane) {
    const int nblk = (s.ncols + 63) >> 6, kb = item / nblk, nb = item - kb * nblk, k0 = 64 * kb, n0 = 64 * nb;
    const int c4 = (lane & 15) * 4, rl = lane >> 4; const bool ok = (n0 + c4) < s.ncols;
    f32x4 v[16];
#pragma unroll
#ifdef PRO_NT
    for (int i = 0; i < 16; ++i) v[i] = ok ? __builtin_nontemporal_load((const GAS f32x4*)(W + (size_t)(k0 + 4 * i + rl) * s.ldw + n0 + c4)) : (f32x4){0.f, 0.f, 0.f, 0.f};
#else
    for (int i = 0; i < 16; ++i) v[i] = ok ? *(const GAS f32x4*)(W + (size_t)(k0 + 4 * i + rl) * s.ldw + n0 + c4) : (f32x4){0.f, 0.f, 0.f, 0.f};
#endif
#pragma unroll
    for (int i = 0; i < 16; ++i) { LAS float* p = scr + (4 * i + rl) * 65 + c4; p[0] = v[i].x; p[1] = v[i].y; p[2] = v[i].z; p[3] = v[i].w; }
    LDS_WAIT(); asm volatile("" ::: "memory");
    const int c = lane & 7; GAS bf16_t* WT = (GAS bf16_t*)(ws + s.dst);
#pragma unroll
    for (int j = 0; j < 8; ++j) { const int n = (lane >> 3) + 8 * j, na = n0 + n; const LAS float* p = scr + (8 * c) * 65 + n;
        u32x4 o; o.x = cvtpk(p[0 * 65], p[1 * 65]); o.y = cvtpk(p[2 * 65], p[3 * 65]); o.z = cvtpk(p[4 * 65], p[5 * 65]); o.w = cvtpk(p[6 * 65], p[7 * 65]);
        if (na < s.ncols) { const int drow = s.row0 + (na / s.blk) * s.stride + (na % s.blk); *(GAS u32x4*)(WT + (size_t)drow * s.K + k0 + 8 * c) = o; } }
    LDS_WAIT(); asm volatile("" ::: "memory");
}
__device__ __forceinline__ void mod_unit(Frame& F, const float* c_, const float* w_ada_, const float* b_ada_, float* MOD_, int unit) {
    const GAS float* c = (const GAS float*)c_;
    const GAS float* w_ada = (const GAS float*)w_ada_;
    const GAS float* b_ada = (const GAS float*)b_ada_;
    GAS float* MOD = (GAS float*)MOD_;
    THREAD_IDS();
    LAS float* sc = (LAS float*)F.lds;
    LAS float* red = (LAS float*)(F.lds + 16384);
    for (int i = tid; i < 4096; i += NTHREADS) { const float v = c[i]; sc[i] = v * sigmoidf_(v); }
    __syncthreads();
    const int l = unit / 96, n = (unit % 96) * 64 + lane;
    const GAS float* wp = w_ada + (size_t)l * 1024 * 6144 + n;
    float a0 = 0.f, a1 = 0.f, a2 = 0.f, a3 = 0.f;
    const int kb = wave * 128;
#pragma unroll 8
    for (int k = 0; k < 128; ++k) { const float w = wp[(size_t)(kb + k) * 6144]; a0 += sc[kb + k] * w; a1 += sc[1024 + kb + k] * w; a2 += sc[2048 + kb + k] * w; a3 += sc[3072 + kb + k] * w; }
    red[(wave * 4 + 0) * 64 + lane] = a0; red[(wave * 4 + 1) * 64 + lane] = a1; red[(wave * 4 + 2) * 64 + lane] = a2; red[(wave * 4 + 3) * 64 + lane] = a3;
    __syncthreads();
    if (tid < 256) { const int b = tid >> 6, ln = tid & 63; float s = 0.f;
#pragma unroll
        for (int w = 0; w < 8; ++w) s += red[(w * 4 + b) * 64 + ln];
        const int nn = (unit % 96) * 64 + ln; MOD[((size_t)l * 4 + b) * 6144 + nn] = s + b_ada[l * 6144 + nn]; }
    __syncthreads();
}
__device__ __forceinline__ void p0_prologue(Frame& F) {
    THREAD_IDS();
    const int gw = F.bx * NWAVES + wave, NGW = F.G * NWAVES;
    if (F.bx < 192) mod_unit(F, karg_in(1), karg_in(2), karg_in(3), (float*)(F.ws + WS_MOD), F.bx);
    LAS unsigned long long* ptab = (LAS unsigned long long*)(F.lds + 140 * 1024);
    if (tid == 0) {
        ptab[6] = (unsigned long long)karg_in(6); ptab[7] = (unsigned long long)karg_in(7); ptab[8] = (unsigned long long)karg_in(8);
        ptab[12] = (unsigned long long)karg_in(12); ptab[13] = (unsigned long long)karg_in(13); ptab[14] = (unsigned long long)karg_in(14);
        ptab[17] = (unsigned long long)karg_in(17); ptab[18] = (unsigned long long)karg_in(18); ptab[19] = (unsigned long long)karg_in(19);
    }
    __syncthreads();
    LAS float* scr = (LAS float*)(F.lds + wave * 16640);
    int si = 0;
    for (int it = gw; it < SEG_ITEMS; it += NGW) {
        while (si + 1 < NSEG && g_segs[si + 1].item0 <= it) ++si;
        const Seg s = g_segs[si];
        const GAS float* W = (const GAS float*)ptab[s.in_idx] + s.src_off;
        transpose_item(W, s, (GAS unsigned char*)F.ws, scr, it - s.item0, lane);
    }
}

template <bool ROUTE>
__device__ __forceinline__ void norm_phase(Frame& F, const float* x_, const float* g_, const float* mod_sh_, const float* mod_sc_, bf16_t* XN_,
                                           const float* Wr_, const float* br_) {
    const GAS float* x = (const GAS float*)x_;
    const GAS float* g = (const GAS float*)g_;
    const GAS float* mod_sh = (const GAS float*)mod_sh_;
    const GAS float* mod_sc = (const GAS float*)mod_sc_;
    GAS bf16_t* XN = (GAS bf16_t*)XN_;
    const GAS float* Wr = (const GAS float*)Wr_;
    const GAS float* br = (const GAS float*)br_;
    THREAD_IDS();
    LAS float* wr_l = (LAS float*)F.lds;
    LAS int* e1s = (LAS int*)(F.lds + 32768); LAS int* e2s = e1s + 64;
    if (ROUTE) { for (int i = tid; i < 8192; i += NTHREADS) wr_l[i] = Wr[i]; __syncthreads(); }
    const int row0 = F.bx * 64 + wave * 8, b = row0 >> 12;
    f32x4 gain[4], sh[4];
#pragma unroll
    for (int j = 0; j < 4; ++j) { const int cidx = 4 * lane + 256 * j;
        const f32x4 gv = *(const GAS f32x4*)(g + cidx), sv = *(const GAS f32x4*)(mod_sc + (size_t)b * 6144 + cidx);
        gain[j] = gv * (sv + 1.0f); sh[j] = *(const GAS f32x4*)(mod_sh + (size_t)b * 6144 + cidx); }
    for (int r = 0; r < 8; ++r) {
        const int row = row0 + r;
        const GAS f32x4* xr = (const GAS f32x4*)(x + (size_t)row * D) + lane;
        f32x4 v[4]; float s = 0.f;
#pragma unroll
        for (int j = 0; j < 4; ++j) { v[j] = xr[64 * j]; s += (v[j].x * v[j].x + v[j].y * v[j].y) + (v[j].z * v[j].z + v[j].w * v[j].w); }
        const float rstd = 1.0f / sqrtf(wave_sum(s) * (1.f / D) + 1e-6f);
        GAS unsigned long long* o8 = (GAS unsigned long long*)(XN + (size_t)row * D) + lane;
#pragma unroll
        for (int j = 0; j < 4; ++j) { v[j] = (v[j] * rstd) * gain[j] + sh[j];
            o8[64 * j] = (unsigned long long)cvtpk(v[j].x, v[j].y) | ((unsigned long long)cvtpk(v[j].z, v[j].w) << 32); }
        if (ROUTE) {
            float lg[8];
#pragma unroll
            for (int e = 0; e < 8; ++e) lg[e] = 0.f;
#pragma unroll
            for (int j = 0; j < 4; ++j)
#pragma unroll
                for (int k = 0; k < 4; ++k) { const LAS f32x4* wp = (const LAS f32x4*)(wr_l + (size_t)(4 * lane + 256 * j + k) * 8); const f32x4 w0 = wp[0], w1 = wp[1]; const float hv = v[j][k];
                    lg[0] += hv * w0.x; lg[1] += hv * w0.y; lg[2] += hv * w0.z; lg[3] += hv * w0.w; lg[4] += hv * w1.x; lg[5] += hv * w1.y; lg[6] += hv * w1.z; lg[7] += hv * w1.w; }
#pragma unroll
            for (int e = 0; e < 8; ++e) lg[e] = wave_sum(lg[e]) + br[e];
            int i1 = 0; float v1 = lg[0];
#pragma unroll
            for (int e = 1; e < 8; ++e) if (lg[e] > v1) { v1 = lg[e]; i1 = e; }
            int i2 = -1; float v2 = -INFINITY;
#pragma unroll
            for (int e = 0; e < 8; ++e) if (e != i1 && lg[e] > v2) { v2 = lg[e]; i2 = e; }
            const float w2 = frcp(1.f + __expf(v1 - v2)), w1 = 1.f - w2;
            if (lane == 0) { e1s[wave * 8 + r] = i1; e2s[wave * 8 + r] = i2; *(f32x2*)(F.ws + WS_RTW + (size_t)row * 8) = (f32x2){w1, w2}; }
        }
    }
    if (ROUTE) {
        __syncthreads();
        if (wave == 0) {
            const int e1 = e1s[lane], e2 = e2s[lane]; int r1 = 0, r2 = 0;
            const unsigned long long lt = (lane == 0) ? 0ull : (~0ull >> (64 - lane));
#pragma unroll
            for (int e = 0; e < 8; ++e) { const unsigned long long b1 = __ballot(e1 == e), b2 = __ballot(e2 == e); const int c1 = __builtin_popcountll(b1);
                if (e1 == e) r1 = __builtin_popcountll(b1 & lt);
                if (e2 == e) r2 = c1 + __builtin_popcountll(b2 & lt);
                if (lane == e) ((unsigned*)(F.ws + WS_WGCNT))[F.bx * 8 + e] = (unsigned)(c1 + __builtin_popcountll(b2)); }
            ((unsigned*)(F.ws + WS_RTE))[F.bx * 64 + lane] = (unsigned)e1 | ((unsigned)e2 << 8) | ((unsigned)r1 << 16) | ((unsigned)r2 << 24);
        }
        __syncthreads();
    }
}
__device__ __forceinline__ void moe_gather_phase(Frame& F, const bf16_t* XN_, bf16_t* XP_) {
    const GAS bf16_t* XN = (const GAS bf16_t*)XN_;
    GAS bf16_t* XP = (GAS bf16_t*)XP_;
    THREAD_IDS();
    LAS unsigned* cnt = (LAS unsigned*)F.lds;
    LAS int* segs = (LAS int*)(F.lds + 8192);
    const unsigned* wg = (const unsigned*)(F.ws + WS_WGCNT);
    for (int i = tid; i < 2048; i += NTHREADS) cnt[i] = wg[i];
    __syncthreads();
    if (tid < 8) { int tot = 0, base = 0; for (int w = 0; w < 256; ++w) { const int c = (int)cnt[w * 8 + tid]; if (w < F.bx) base += c; tot += c; } segs[32 + tid] = tot; segs[8 + tid] = base; }
    __syncthreads();
    if (tid == 0) { int st = 0; for (int e = 0; e < 8; ++e) { segs[e] = st; st += (segs[32 + e] + 255) & ~255; } segs[16] = st;
        if (F.bx == 0) { int* tab = (int*)(F.ws + WS_TILETAB); tab[0] = st >> 8; for (int e = 0; e < 8; ++e) { const int t0 = segs[e] >> 8, t1 = (e < 7 ? segs[e + 1] : st) >> 8; for (int t = t0; t < t1; ++t) tab[1 + t] = e; } } }
    __syncthreads();
    for (int r = 0; r < 8; ++r) {
        const int row = F.bx * 64 + wave * 8 + r;
        const unsigned rt = ((const unsigned*)(F.ws + WS_RTE))[row];
        const int e1 = rt & 255, e2 = (rt >> 8) & 255, r1 = (rt >> 16) & 255, r2 = rt >> 24;
        const int p1 = segs[e1] + segs[8 + e1] + r1, p2 = segs[e2] + segs[8 + e2] + r2;
        const GAS u32x4* src = (const GAS u32x4*)(XN + (size_t)row * D) + lane; const u32x4 a = src[0], bq = src[64];
        GAS u32x4* d1 = (GAS u32x4*)(XP + (size_t)p1 * D) + lane; d1[0] = a; d1[64] = bq;
        GAS u32x4* d2 = (GAS u32x4*)(XP + (size_t)p2 * D) + lane; d2[0] = a; d2[64] = bq;
        if (lane == 0) { int* pos = (int*)(F.ws + WS_POS) + (size_t)row * 2; pos[0] = p1; pos[1] = p2; }
    }
}
__device__ __forceinline__ void final_phase(Frame& F, float* x_, const bf16_t* Y_, const bf16_t* Z_, const float* g2_, const float* fg_) {
    GAS float* x = (GAS float*)x_;
    const GAS bf16_t* Y = (const GAS bf16_t*)Y_;
    const GAS bf16_t* Z = (const GAS bf16_t*)Z_;
    const GAS float* g2 = (const GAS float*)g2_;
    const GAS float* fg = (const GAS float*)fg_;
    THREAD_IDS();
    const int row0 = F.bx * 64 + wave * 8, b = row0 >> 12;
    f32x4 gate[4], fgv[4];
#pragma unroll
    for (int j = 0; j < 4; ++j) { const int cidx = 4 * lane + 256 * j; gate[j] = *(const GAS f32x4*)(g2 + (size_t)b * 6144 + cidx); fgv[j] = *(const GAS f32x4*)(fg + cidx); }
    for (int r = 0; r < 8; ++r) {
        const int row = row0 + r;
        const int* pos = (const int*)(F.ws + WS_POS) + (size_t)row * 2; const int p1 = pos[0], p2 = pos[1];
        const f32x2 wv = *(const f32x2*)(F.ws + WS_RTW + (size_t)row * 8);
        GAS f32x4* xr = (GAS f32x4*)(x + (size_t)row * D) + lane;
        const GAS u32x2* y1 = (const GAS u32x2*)(Y + (size_t)p1 * D) + lane; const GAS u32x2* y2 = (const GAS u32x2*)(Y + (size_t)p2 * D) + lane;
        const GAS u32x2* z1 = (const GAS u32x2*)(Z + (size_t)p1 * D) + lane; const GAS u32x2* z2 = (const GAS u32x2*)(Z + (size_t)p2 * D) + lane;
        f32x4 v[4]; float s = 0.f;
#pragma unroll
        for (int j = 0; j < 4; ++j) { const u32x2 a = y1[64 * j], c = y2[64 * j]; u32x2 a2 = {0u, 0u}, c2 = {0u, 0u};
            a2 = z1[64 * j]; c2 = z2[64 * j];
            const f32x4 ya = (f32x4){bf_lo(a.x), bf_hi(a.x), bf_lo(a.y), bf_hi(a.y)} + (f32x4){bf_lo(a2.x), bf_hi(a2.x), bf_lo(a2.y), bf_hi(a2.y)};
            const f32x4 yc = (f32x4){bf_lo(c.x), bf_hi(c.x), bf_lo(c.y), bf_hi(c.y)} + (f32x4){bf_lo(c2.x), bf_hi(c2.x), bf_lo(c2.y), bf_hi(c2.y)};
            v[j] = xr[64 * j] + gate[j] * (ya * wv.x + yc * wv.y);
            s += (v[j].x * v[j].x + v[j].y * v[j].y) + (v[j].z * v[j].z + v[j].w * v[j].w); }
        const float rstd = 1.0f / sqrtf(wave_sum(s) * (1.f / D) + 1e-6f);
#pragma unroll
        for (int j = 0; j < 4; ++j) xr[64 * j] = (v[j] * rstd) * fgv[j];
    }
}

__device__ __forceinline__ int pi_perm(int r) { return (r & 0x13) | ((r & 4) << 1) | ((r & 8) >> 1); }
__device__ __forceinline__ u32x4 tile_gload(const GAS bf16_t* g, size_t pitch, int tid) {
    const int row = tid >> 3, pc = tid & 7, c = pc ^ ((row >> 1) & 7);
    return *(const GAS u32x4*)(g + (size_t)row * pitch + c * 8);
}
__device__ __forceinline__ bf16x8 lfrag(const LAS unsigned char* p) { return *(const LAS bf16x8*)p; }
__device__ __forceinline__ bf16x8 pack8(const f32x16& p, int s) {
    u32x4 w; w.x = cvtpk(p[8 * s + 0], p[8 * s + 1]); w.y = cvtpk(p[8 * s + 2], p[8 * s + 3]); w.z = cvtpk(p[8 * s + 4], p[8 * s + 5]); w.w = cvtpk(p[8 * s + 6], p[8 * s + 7]);
    return __builtin_bit_cast(bf16x8, w);
}
__device__ __forceinline__ int t5_bucket(int rel) {
    const int n = rel < 0 ? -rel : rel;
    const int large = 8 + (n >= 12) + (n >= 16) + (n >= 23) + (n >= 32) + (n >= 46) + (n >= 64) + (n >= 91);
    return (rel > 0 ? 16 : 0) + (n < 8 ? n : large);
}
__device__ __forceinline__ float max3f(float a, float b, float c) { float r; asm("v_max3_f32 %0, %1, %2, %3" : "=v"(r) : "v"(a), "v"(b), "v"(c)); return r; }
__device__ __forceinline__ float max16(const f32x16& a) {
    float m0 = max3f(a[0], a[1], a[2]), m1 = max3f(a[3], a[4], a[5]); m0 = max3f(m0, a[6], a[7]); m1 = max3f(m1, a[8], a[9]);
    m0 = max3f(m0, a[10], a[11]); m1 = max3f(m1, a[12], a[13]); m0 = max3f(m0, a[14], a[15]);
    return max3f(m0, m1, m1);
}
__device__ __forceinline__ unsigned bitmask1(unsigned w, int bit) { int t = __builtin_amdgcn_sbfe((int)w, bit, 1); asm("" : "+v"(t)); return (unsigned)t; }
#define MFMA32(a, b, c) __builtin_amdgcn_mfma_f32_32x32x16_bf16((a), (b), (c), 0, 0, 0)

#ifndef TKG
#define TKG 8
#endif
constexpr int TKS = 4, TKP = 3;
__device__ __forceinline__ void topk_wg(Frame& F, int b, int m, const bf16_t* PROJ_, const float* WI_, unsigned long long* MASK_) {
    const GAS bf16_t* PROJ = (const GAS bf16_t*)PROJ_;
    const GAS float* WI = (const GAS float*)WI_;
    GAS unsigned long long* MASK = (GAS unsigned long long*)MASK_;
    THREAD_IDS(); const int n16 = lane & 15, kq = lane >> 4, j = m >> 3;
    LAS unsigned* scu = (LAS unsigned*)F.lds;
#define TK_CI(k) (8 * (k) + (((k) & 1) ? 7 - (m & 7) : (m & 7)))
    bf16x8 af[2][2]; f32x4 wv[2]; bf16x8 bfr[TKS][2];
#define TK_LOADQ(cin) do { const int t0n_ = b * SEQ + 64 * (cin) + 8 * j; _Pragma("unroll") for (int mt = 0; mt < 2; ++mt) { _Pragma("unroll") for (int jk = 0; jk < 2; ++jk) \
        af[mt][jk] = *(const GAS bf16x8*)(PROJ + (size_t)(t0n_ + 4 * mt + (n16 >> 2)) * NP + C_QI + (n16 & 3) * 64 + 32 * jk + 8 * kq); \
        wv[mt] = *(const GAS f32x4*)(WI + (size_t)(t0n_ + 4 * mt + kq) * 4); } } while (0)
#define TK_LOADG(g, nb) do { _Pragma("unroll") for (int u = 0; u < TKS; ++u) { const int kb_ = ((g) * 8 + wave) * TKS + u; const int kc_ = kb_ < (nb) ? kb_ : 0; \
        const GAS bf16_t* kp_ = PROJ + (size_t)(b * SEQ + 16 * kc_ + n16) * NP + C_KI + 8 * kq; bfr[u][0] = *(const GAS bf16x8*)kp_; bfr[u][1] = *(const GAS bf16x8*)(kp_ + 32); } } while (0)
#define TK_MULG(g, nb) do { _Pragma("unroll") for (int u = 0; u < TKS; ++u) { const int kb_ = ((g) * 8 + wave) * TKS + u; if (kb_ < (nb)) { _Pragma("unroll") for (int mt = 0; mt < 2; ++mt) { \
        f32x4 acc_ = {0.f, 0.f, 0.f, 0.f}; acc_ = __builtin_amdgcn_mfma_f32_16x16x32_bf16(af[mt][0], bfr[u][0], acc_, 0, 0, 0); acc_ = __builtin_amdgcn_mfma_f32_16x16x32_bf16(af[mt][1], bfr[u][1], acc_, 0, 0, 0); \
        const float s_ = wv[mt].x * fmaxf(acc_.x, 0.f) + wv[mt].y * fmaxf(acc_.y, 0.f) + wv[mt].z * fmaxf(acc_.z, 0.f) + wv[mt].w * fmaxf(acc_.w, 0.f); \
        const unsigned sb_ = __float_as_uint(s_ + 0.0f);     \
        scu[(4 * mt + kq) * 4096 + ((16 * kb_ + n16) ^ (16 * (kq & 1)))] = sb_ ^ (((unsigned)((int)sb_ >> 31)) | 0x80000000u); } } } } while (0)
    int k = 0;
    for (; k < 8 && TK_CI(k) < 4; ++k) { const int ci = TK_CI(k);
        MASK[(size_t)(b * SEQ + 64 * ci + 8 * j + wave) * 64 + lane] = (lane < ci + 1) ? ~0ull : 0ull; }
    if (k < 8) {
        const int nb = 4 * (TK_CI(k) + 1); TK_LOADQ(TK_CI(k));
        for (int g = 0; (g * 8 + wave) * TKS < nb; ++g) { TK_LOADG(g, nb); TK_MULG(g, nb); }
    }
    __syncthreads();
    for (; k < 8; ++k) {
        const int ci = TK_CI(k), nreg = ci + 1, t0 = b * SEQ + 64 * ci + 8 * j;
        unsigned key[64];
#pragma unroll
        for (int r = 0; r < 64; ++r) { const unsigned kv = scu[wave * 4096 + ((64 * r + lane) ^ (16 * (wave & 1)))]; key[r] = (r < nreg) ? kv : 0u; }
        __syncthreads();
        const bool has_next = k + 1 < 8; const int nbn = has_next ? 4 * (TK_CI(k + 1) + 1) : 0;
        if (has_next) TK_LOADQ(TK_CI(k + 1));
        unsigned Tt = 0u; int cge = 0, bit = 32, g = 0;
        for (;;) {
            const bool more = (g * 8 + wave) * TKS < nbn;
            if (!more && bit < 0) break;
            if (more) TK_LOADG(g, nbn);
            for (int ps = 0; ps < TKP && bit >= 0; ++ps) {
                const unsigned cand = (bit == 32) ? 0x80000001u : (bit == 31) ? 0x80000000u : (Tt | (1u << bit)); int vc = 0;
#pragma unroll
                for (int g4 = 0; g4 < 64 / TKG; ++g4) if (g4 * TKG < nreg) {
#pragma unroll
                    for (int r = 0; r < TKG; r += 4)
                        asm volatile("v_cmp_ge_u32_e64 s[80:81], %1, %5\n\tv_cmp_ge_u32_e64 s[82:83], %2, %5\n\tv_cmp_ge_u32_e64 s[84:85], %3, %5\n\tv_cmp_ge_u32_e64 s[86:87], %4, %5\n\t"
                                     "v_addc_co_u32_e64 %0, s[80:81], %0, 0, s[80:81]\n\tv_addc_co_u32_e64 %0, s[82:83], %0, 0, s[82:83]\n\t"
                                     "v_addc_co_u32_e64 %0, s[84:85], %0, 0, s[84:85]\n\tv_addc_co_u32_e64 %0, s[86:87], %0, 0, s[86:87]"
                                     : "+v"(vc) : "v"(key[g4 * TKG + r]), "v"(key[g4 * TKG + r + 1]), "v"(key[g4 * TKG + r + 2]), "v"(key[g4 * TKG + r + 3]), "s"(cand)
                                     : "s80", "s81", "s82", "s83", "s84", "s85", "s86", "s87");
                }
                const int cnt = wave_sum_i32(vc);
                if (bit == 32) { if (cnt == 256) { Tt = cand; cge = 256; bit = -1; } else if (cnt > 256) { Tt = 0x80000000u; bit = 30; } else bit = 31; continue; }
                if (bit == 31) { if (cnt >= 256) { Tt = cand; cge = cnt; bit = -1; } else bit = 30; continue; }
                if (cnt >= 256) { Tt = cand; cge = cnt; if (cnt == 256) { bit = -1; continue; } }
                --bit;
            }
            if (more) { TK_MULG(g, nbn); ++g; }
        }
        {
            int need = 4096;
            if (cge != 256) { int cgt = 0;
#pragma unroll
                for (int r = 0; r < 64; ++r) { cgt += __builtin_popcountll(__ballot(key[r] > Tt)); __builtin_amdgcn_sched_barrier(0); }
                need = 256 - cgt; }
            unsigned mlo = 0u, mhi = 0u;
#pragma unroll
            for (int r = 0; r < 64; ++r) {
                const unsigned long long eq = __ballot(key[r] == Tt && r < nreg);
                const int rank = (int)__builtin_amdgcn_mbcnt_hi((unsigned)(eq >> 32), __builtin_amdgcn_mbcnt_lo((unsigned)eq, 0u));
                const unsigned long long ge = __ballot(key[r] > Tt || (key[r] == Tt && r < nreg && rank < need));
                need -= __builtin_popcountll(eq);
                asm volatile("s_mov_b32 s80, %2\n\ts_mov_b32 s81, %3\n\ts_nop 4\n\tv_writelane_b32 %0, s80, %4\n\tv_writelane_b32 %1, s81, %4"
                             : "+v"(mlo), "+v"(mhi) : "s"((unsigned)ge), "s"((unsigned)(ge >> 32)), "n"(r) : "s80", "s81");
                __builtin_amdgcn_sched_barrier(0); }
            MASK[(size_t)(t0 + wave) * 64 + lane] = ((unsigned long long)mhi << 32) | mlo;
        }
        __syncthreads();
    }
#undef TK_CI
#undef TK_LOADQ
#undef TK_LOADG
#undef TK_MULG
}

template <int MODE, int ORD, int ATP = 0>
__device__ __forceinline__ void attn_unit(Frame& F, int b, int h, int qb, const bf16_t* PROJ_, const bf16_t* VT_, const unsigned long long* MASK_, bf16_t* OUT_,
                                          const float* rel_bias_, const float* lamp_, const float* subg_, float lam_init) {
    const GAS bf16_t* PROJ = (const GAS bf16_t*)PROJ_; const GAS bf16_t* VT = (const GAS bf16_t*)VT_; const GAS unsigned long long* MASK = (const GAS unsigned long long*)MASK_;
    GAS bf16_t* OUT = (GAS bf16_t*)OUT_; const GAS float* rel_bias = (const GAS float*)rel_bias_; const GAS float* lamp = (const GAS float*)lamp_; const GAS float* subg = (const GAS float*)subg_;
    constexpr int NDB = MODE ? 4 : 2, KS = MODE ? 16384 : 8192, VS = MODE ? 16384 : 8192, KSL = MODE ? 2 : 3, VSL = MODE ? 4 : 5, FD = MODE ? 2 : 3, VR = KSL * KS, BT = VR + VSL * VS;
    THREAD_IDS(); const int r32 = lane & 31, half = lane >> 5, map = MODE ? (wave >> 2) : 0, wq = MODE ? (wave & 3) : wave;
    LAS unsigned char* buf = F.lds; LAS float* btab = (LAS float*)(F.lds + BT);
    const int tokb = b * SEQ, qw = (MODE ? qb * 128 : qb * 256) + 32 * wq, ntw = (qw >> 6) + 1, nt = MODE ? 2 * qb + 2 : 4 * qb + 4;
    const float bfar = rel_bias[15 * 12 + (MODE ? 8 : 0) + h] * LOG2E;
    if (tid < 192) btab[tid] = rel_bias[t5_bucket(tid - 128) * 12 + (MODE ? 8 : 0) + h] * LOG2E - bfar;
    bf16x8 qf[4];
    LAS bf16x8* qpark = (LAS bf16x8*)(F.lds + BT + 1024 + wave * 4096) + lane;
#pragma unroll
    for (int ds = 0; ds < 4; ++ds) { qf[ds] = *(const GAS bf16x8*)(PROJ + (size_t)(tokb + qw + r32) * NP + (MODE ? C_QB + h * 128 + map * 64 : C_QA + h * 64) + 16 * ds + 8 * half);
        qpark[ds * 64] = qf[ds]; }
    const int prow = pi_perm(r32), swk = (prow >> 1) & 7, swv = (r32 >> 1) & 7;
    const int koff0 = map * 8192 + prow * 128 + ((half ^ swk) << 4), voff0 = VR + r32 * 128 + ((half ^ swv) << 4);
#define koff(k) (koff0 ^ ((k) << 5))
#define voff(k) (voff0 ^ ((k) << 5))
    const GAS bf16_t* kg = PROJ + (size_t)tokb * NP + (MODE ? C_KB + h * 128 : C_KA + h * 64);
    const GAS bf16_t* vg = VT + (size_t)(MODE ? 512 + h * 128 : h * 64) * VTP + tokb;
    const GAS unsigned long long* mrow = MASK + (size_t)(tokb + qw + r32) * 64;
    float m_run = 0.f, l_run = 0.f, cref = 0.f, sref = 0.f, nref = 0.f; f32x16 O[NDB], cv;
#pragma unroll
    for (int d = 0; d < NDB; ++d)
#pragma unroll
        for (int i = 0; i < 16; ++i) O[d][i] = 0.f;
    const int drow = tid >> 3, dch = ((tid & 7) ^ ((drow >> 1) & 7)) * 8;
    const GAS bf16_t* kgl = kg + (size_t)drow * NP + dch; const GAS bf16_t* vgl = vg + (size_t)drow * VTP + dch;
#ifdef AT_SETPRIO
#define AT_PRIO(p) __builtin_amdgcn_s_setprio(p)
#else
#define AT_PRIO(p) do { } while (0)
#endif
#define AT_DMA(gp, off) __builtin_amdgcn_global_load_lds((const GAS unsigned*)(gp), (LAS unsigned*)(buf + (off) + wave * 1024), 16, 0, 0)
#define AT_KLOAD(tt) do { const int t_ = (tt); const GAS bf16_t* kn_ = kgl + (size_t)t_ * 64 * NP; const int ko_ = (t_ % KSL) * KS; AT_DMA(kn_, ko_); if (MODE) AT_DMA(kn_ + 64, ko_ + 8192); } while (0)
#define AT_VLOAD(tt) do { const int t_ = (tt); const GAS bf16_t* vn_ = vgl + t_ * 64; const int vo_ = VR + (t_ % VSL) * VS; AT_DMA(vn_, vo_); if (MODE) AT_DMA(vn_ + (size_t)64 * VTP, vo_ + 8192); } while (0)
#define AT_QK(S0, S1, tt, RF) do { const int t_ = (tt); const LAS unsigned char* kb_ = buf + (t_ % KSL) * KS; const bool far_ = ATP ? true : (64 * t_ <= qw - 154); RF = cref; \
        AT_PRIO(1); { const bf16x8 q_ = qpark[0]; if (MODE) { const float c_ = bfar - cref; _Pragma("unroll") for (int i = 0; i < 16; ++i) { S0[i] = c_; S1[i] = c_; } S0 = MFMA32(lfrag(kb_ + koff(0)), q_, S0); S1 = MFMA32(lfrag(kb_ + 4096 + koff(0)), q_, S1); } \
          else { S0 = MFMA32(lfrag(kb_ + koff(0)), q_, cv); S1 = MFMA32(lfrag(kb_ + 4096 + koff(0)), q_, cv); } } \
        _Pragma("unroll") for (int ds = 1; ds < 4; ++ds) { const bf16x8 q_ = qpark[ds * 64]; S0 = MFMA32(lfrag(kb_ + koff(ds)), q_, S0); S1 = MFMA32(lfrag(kb_ + 4096 + koff(ds)), q_, S1); } AT_PRIO(0); \
        if (!far_) { const int base_ = 64 * t_ + 8 * half - (qw + r32) + 128; \
            _Pragma("unroll") for (int i = 0; i < 16; ++i) { const int o_ = 16 * (i >> 3) + (i & 7); int i0 = base_ + o_, i1 = base_ + 32 + o_; i0 = i0 < 0 ? 0 : i0; i1 = i1 < 0 ? 0 : i1; S0[i] += btab[i0]; S1[i] += btab[i1]; } } } while (0)
#define AT_SETREF() do { cref = m_run; if (!MODE) { _Pragma("unroll") for (int i = 0; i < 16; ++i) cv[i] = bfar - m_run; } } while (0)
#define AT_PV(tt) do { const LAS unsigned char* vb_ = buf + ((tt) % VSL) * VS; AT_PRIO(1); \
        _Pragma("unroll") for (int db = 0; db < NDB; ++db) { \
            O[db] = MFMA32(lfrag(vb_ + db * 4096 + voff(0)), pf0, O[db]); O[db] = MFMA32(lfrag(vb_ + db * 4096 + voff(1)), pf1, O[db]); \
            O[db] = MFMA32(lfrag(vb_ + db * 4096 + voff(2)), pf2, O[db]); O[db] = MFMA32(lfrag(vb_ + db * 4096 + voff(3)), pf3, O[db]); } AT_PRIO(0); } while (0)
    AT_KLOAD(0); AT_VLOAD(0); AT_KLOAD(1); AT_VLOAD(1); if (FD == 3) { AT_KLOAD(2 < nt ? 2 : nt - 1); AT_VLOAD(2 < nt ? 2 : nt - 1); }
    unsigned long long mcur = 0ull, mnext = 0ull;
    if (!MODE) { mcur = mrow[0]; mnext = mrow[ntw > 1 ? 1 : 0]; }
    __syncthreads();
    f32x16 s0, s1, n0, n1; bf16x8 pf0, pf1, pf2, pf3;
    {   bf16x8 z;
#pragma unroll
        for (int i = 0; i < 8; ++i) z[i] = 0;
        pf0 = z; pf1 = z; pf2 = z; pf3 = z; }
#pragma unroll
    for (int i = 0; i < 16; ++i) { n0[i] = 0.f; n1[i] = 0.f; }
    AT_SETREF();
    AT_QK(s0, s1, 0, sref);
    float mtc = fmaxf(max16(s0), max16(s1)); mtc = fmaxf(mtc, xhalf(mtc)) + sref; float mtn = mtc;
#define AT_SOFTMAX(s0, s1, sref) do { if (ATP || t < ntw) { \
            float mt = fmaxf(max16(s0), max16(s1)); mt = fmaxf(mt, xhalf(mt)) + sref;                   \
            if (!ATP && (t == 0 || __any(mt > m_run + 8.0f))) {                                                   \
                const float mn = (t == 0) ? mt : fmaxf(m_run, mt); alpha = (t == 0) ? 1.f : fexp2(m_run - mn); l_run *= alpha; m_run = mn; resc = (t != 0); AT_SETREF(); } \
            const float dl = sref - m_run; \
            if (!ATP && __any(dl != 0.f)) { _Pragma("unroll") for (int i = 0; i < 16; ++i) { s0[i] += dl; s1[i] += dl; } }        \
            float ls = 0.f; \
            if (!MODE) { \
                const unsigned long long mw = mcur >> (8 * half); const unsigned mlo = (unsigned)mw, mhi = (unsigned)(mw >> 32); \
                _Pragma("unroll") for (int i = 0; i < 16; ++i) { const int bitp = 16 * (i >> 3) + (i & 7); \
                    const float p0 = __uint_as_float(__float_as_uint(fexp2(s0[i])) & bitmask1(mlo, bitp)); \
                    const float p1 = __uint_as_float(__float_as_uint(fexp2(s1[i])) & bitmask1(mhi, bitp)); \
                    s0[i] = p0; s1[i] = p1; ls += p0 + p1; } \
            } else { \
                _Pragma("unroll") for (int i = 0; i < 16; ++i) { s0[i] = fexp2(s0[i]); s1[i] = fexp2(s1[i]); ls += s0[i] + s1[i]; } \
            } \
            l_run += ls; } \
        if (resc) { _Pragma("unroll") for (int d = 0; d < NDB; ++d) _Pragma("unroll") for (int i = 0; i < 16; ++i) O[d][i] *= alpha; } \
        if (ATP || t < ntw) { pf0 = pack8(s0, 0); pf1 = pack8(s0, 1); pf2 = pack8(s1, 0); pf3 = pack8(s1, 1); } } while (0)
#define AT_HEAD() \
        unsigned long long mfut = 0ull; \
        if (!MODE && (ATP ? true : (t + 2 < ntw))) mfut = mrow[ATP ? ((t + 2) & 63) : t + 2]; \
        asm volatile("" ::: "memory"); \
        AT_KLOAD(t + FD < nt ? t + FD : nt - 1); AT_VLOAD(t + FD < nt ? t + FD : nt - 1);        \
        float alpha = 1.f; bool resc = false;
#define AT_TAIL() \
        s0 = n0; s1 = n1; sref = nref; mcur = mnext; mnext = mfut; mtc = mtn; \
          \
        if (MODE) asm volatile("s_waitcnt vmcnt(0) lgkmcnt(0)" ::: "memory"); else asm volatile("s_waitcnt vmcnt(3) lgkmcnt(0)" ::: "memory"); \
        __builtin_amdgcn_s_barrier(); asm volatile("" ::: "memory");
#define AT_STEP_G() do { AT_HEAD() \
        if (ORD == 0) { \
            if (ATP || t + 1 < ntw) { AT_QK(n0, n1, (ATP ? (t + 1 < nt ? t + 1 : t) : t + 1), nref); mtn = fmaxf(max16(n0), max16(n1)); mtn = fmaxf(mtn, xhalf(mtn)) + nref; } \
            if (ATP || (t >= 1 && t <= ntw)) AT_PV(ATP ? (t >= 1 ? t - 1 : 0) : t - 1); \
            AT_SOFTMAX(s0, s1, sref);                                \
        } else { \
            if (ATP || (t >= 1 && t <= ntw)) AT_PV(ATP ? (t >= 1 ? t - 1 : 0) : t - 1); \
            AT_SOFTMAX(s0, s1, sref); \
            if (ATP || t + 1 < ntw) { AT_QK(n0, n1, (ATP ? (t + 1 < nt ? t + 1 : t) : t + 1), nref); mtn = fmaxf(max16(n0), max16(n1)); mtn = fmaxf(mtn, xhalf(mtn)) + nref; } \
        } \
        AT_TAIL() } while (0)
#define AT_STEP_F() do { AT_HEAD() \
              \
              \
            if (__any(mtc > m_run + 8.0f)) { const float mn = fmaxf(m_run, mtc); alpha = fexp2(m_run - mn); l_run *= alpha; m_run = mn; resc = true; AT_SETREF(); } \
            { const float dl = sref - m_run; if (__any(dl != 0.f)) { _Pragma("unroll") for (int i = 0; i < 16; ++i) { s0[i] += dl; s1[i] += dl; } } } \
            { const LAS unsigned char* kb_ = buf + ((t + 1) % KSL) * KS; nref = cref; \
              { const bf16x8 q_ = qpark[0]; if (MODE) { const float c_ = bfar - cref; _Pragma("unroll") for (int i = 0; i < 16; ++i) { n0[i] = c_; n1[i] = c_; } n0 = MFMA32(lfrag(kb_ + koff(0)), q_, n0); n1 = MFMA32(lfrag(kb_ + 4096 + koff(0)), q_, n1); } \
                else { n0 = MFMA32(lfrag(kb_ + koff(0)), q_, cv); n1 = MFMA32(lfrag(kb_ + 4096 + koff(0)), q_, cv); } } \
              _Pragma("unroll") for (int ds = 1; ds < 4; ++ds) { const bf16x8 q_ = qpark[ds * 64]; n0 = MFMA32(lfrag(kb_ + koff(ds)), q_, n0); n1 = MFMA32(lfrag(kb_ + 4096 + koff(ds)), q_, n1); } } \
            AT_PV(t - 1); \
            { float ls = 0.f; \
              if (!MODE) { const unsigned long long mw = mcur >> (8 * half); const unsigned mlo = (unsigned)mw, mhi = (unsigned)(mw >> 32); \
                _Pragma("unroll") for (int i = 0; i < 16; ++i) { const int bitp = 16 * (i >> 3) + (i & 7); \
                    const float p0 = __uint_as_float(__float_as_uint(fexp2(s0[i])) & bitmask1(mlo, bitp)); const float p1 = __uint_as_float(__float_as_uint(fexp2(s1[i])) & bitmask1(mhi, bitp)); \
                    s0[i] = p0; s1[i] = p1; ls += p0 + p1; } \
              } else { _Pragma("unroll") for (int i = 0; i < 16; ++i) { s0[i] = fexp2(s0[i]); s1[i] = fexp2(s1[i]); ls += s0[i] + s1[i]; } } \
              l_run += ls; } \
            pf0 = pack8(s0, 0); pf1 = pack8(s0, 1); pf2 = pack8(s1, 0); pf3 = pack8(s1, 1); \
            mtn = fmaxf(max16(n0), max16(n1)); mtn = fmaxf(mtn, xhalf(mtn)) + nref; \
            if (resc) { _Pragma("unroll") for (int d = 0; d < NDB; ++d) _Pragma("unroll") for (int i = 0; i < 16; ++i) O[d][i] *= alpha; } \
        AT_TAIL() } while (0)
    {
        const int tfe = (qw >= 154 + 128 && !ATP) ? (qw - 154) / 64 : 1;
        int t = 0;
        for (; t < 1; ++t) AT_STEP_G();
        for (; t < tfe; ++t) AT_STEP_F();
        for (; t < nt; ++t) AT_STEP_G();
    }
#undef AT_HEAD
#undef AT_TAIL
#undef AT_STEP_G
#undef AT_STEP_F
#undef AT_SOFTMAX
#undef AT_SETREF
    if (ntw == nt) AT_PV(nt - 1);
#undef AT_KLOAD
#undef AT_VLOAD
#undef AT_DMA
#undef AT_PRIO
#undef AT_QK
#undef AT_PV
#undef koff
#undef voff
    const float inv = frcp(l_run + xhalf(l_run));
    if (!MODE) {
        LAS unsigned char* xs = (LAS unsigned char*)(F.lds + BT + 1024 + wave * 4096);
#pragma unroll
        for (int db = 0; db < 2; ++db)
#pragma unroll
            for (int g = 0; g < 4; ++g) { u32x2 w; w.x = cvtpk(O[db][4 * g] * inv, O[db][4 * g + 1] * inv); w.y = cvtpk(O[db][4 * g + 2] * inv, O[db][4 * g + 3] * inv);
                *(LAS u32x2*)(xs + r32 * 128 + (((4 * db + g) ^ (r32 & 7)) << 4) + 8 * half) = w; }
#pragma unroll
        for (int i = 0; i < 4; ++i) { const int row = (lane >> 3) + 8 * i, ch = lane & 7;
            const u32x4 t = *(const LAS u32x4*)(xs + row * 128 + ((ch ^ (row & 7)) << 4));
            *(GAS u32x4*)(OUT + (size_t)(tokb + qw + row) * 512 + h * 64 + ch * 8) = t; }
        __syncthreads();
    } else {
        const float la = lamp[lane] * lamp[64 + lane], lb = lamp[128 + lane] * lamp[192 + lane];
        const float lam = __expf(wave_sum(la)) - __expf(wave_sum(lb)) + lam_init;
        __syncthreads();
        LAS float* ex = (LAS float*)(F.lds + wq * 16384);
        if (map == 1) {
            const float f = lam * inv;
#pragma unroll
            for (int db = 0; db < NDB; ++db)
#pragma unroll
                for (int i = 0; i < 16; ++i) ex[(db * 16 + i) * 64 + lane] = O[db][i] * f;
        }
        __syncthreads();
        if (map == 0) {
            float ss = 0.f;
#pragma unroll
            for (int db = 0; db < NDB; ++db)
#pragma unroll
                for (int i = 0; i < 16; ++i) { const float o = O[db][i] * inv - ex[(db * 16 + i) * 64 + lane]; O[db][i] = o; ss += o * o; }
            ss += xhalf(ss);
            const float rs = (1.0f / sqrtf(ss * (1.f / 128.f) + 1e-5f)) * (1.0f - lam_init);
            LAS unsigned char* xs = (LAS unsigned char*)ex;
#pragma unroll
            for (int db = 0; db < NDB; ++db)
#pragma unroll
                for (int g = 0; g < 4; ++g) { const f32x4 sg = *(const GAS f32x4*)(subg + 32 * db + 8 * g + 4 * half);
                    u32x2 w; w.x = cvtpk(O[db][4 * g] * rs * sg.x, O[db][4 * g + 1] * rs * sg.y); w.y = cvtpk(O[db][4 * g + 2] * rs * sg.z, O[db][4 * g + 3] * rs * sg.w);
                    *(LAS u32x2*)(xs + r32 * 256 + (((4 * db + g) ^ (r32 & 7)) << 4) + 8 * half) = w; }
#pragma unroll
            for (int i = 0; i < 8; ++i) { const int row = (lane >> 4) + 4 * i, ch = lane & 15;
                const u32x4 t = *(const LAS u32x4*)(xs + row * 256 + ((ch ^ (row & 7)) << 4));
                *(GAS u32x4*)(OUT + (size_t)(tokb + qw + row) * 512 + h * 128 + ch * 8) = t; }
        }
        __syncthreads();
    }
}

constexpr float SB_STOP = 48.f;
__device__ __forceinline__ void sb_unit(Frame& F, int b, int h, int qb, const bf16_t* PROJ_, const bf16_t* VT_, bf16_t* OC_) {
    const GAS bf16_t* PROJ = (const GAS bf16_t*)PROJ_;
    const GAS bf16_t* VT = (const GAS bf16_t*)VT_;
    GAS bf16_t* OC = (GAS bf16_t*)OC_;
    THREAD_IDS(); const int r32 = lane & 31, half = lane >> 5;
    LAS unsigned char* buf = F.lds; volatile LAS int* done_it = (volatile LAS int*)(F.lds + 32768);
    const int tokb = b * SEQ, qw = qb * 256 + 32 * wave, td = qw >> 6, tmax = 4 * qb + 3, qrel = (qw & 63) + r32;
    if (tid < 8) done_it[tid] = 0x7fffffff;
    bf16x8 qf[4];
#pragma unroll
    for (int ds = 0; ds < 4; ++ds) qf[ds] = *(const GAS bf16x8*)(PROJ + (size_t)(tokb + qw + r32) * NP + C_QC + h * 64 + 16 * ds + 8 * half);
    const int prow = pi_perm(r32), swk = (prow >> 1) & 7, swv = (r32 >> 1) & 7;
    int koff[4], voff[4];
#pragma unroll
    for (int k = 0; k < 4; ++k) { koff[k] = prow * 128 + (((2 * k + half) ^ swk) << 4); voff[k] = 8192 + r32 * 128 + (((2 * k + half) ^ swv) << 4); }
    const GAS bf16_t* kg = PROJ + (size_t)tokb * NP + C_KC + h * 64;
    const GAS bf16_t* vg = VT + (size_t)(1024 + h * 64) * VTP + tokb;
    float carry = 0.f; bool done = false; f32x16 O[2];
#pragma unroll
    for (int i = 0; i < 16; ++i) { O[0][i] = 0.f; O[1][i] = 0.f; }
    u32x4 kreg = tile_gload(kg + (size_t)tmax * 64 * NP, NP, tid), vreg = tile_gload(vg + tmax * 64, VTP, tid);
    *(LAS u32x4*)(buf + tid * 16) = kreg; *(LAS u32x4*)(buf + 8192 + tid * 16) = vreg;
    __syncthreads();
    for (int k = 0; k <= tmax; ++k) {
        const int t = tmax - k;
        const LAS unsigned char* cur = buf + (k & 1) * 16384;
        if (t > 0) { kreg = tile_gload(kg + (size_t)(t - 1) * 64 * NP, NP, tid); vreg = tile_gload(vg + (t - 1) * 64, VTP, tid); }
        if (t <= td && !done) {
            f32x16 z0, z1;
#pragma unroll
            for (int i = 0; i < 16; ++i) { z0[i] = 0.f; z1[i] = 0.f; }
#pragma unroll
            for (int ds = 0; ds < 4; ++ds) { z0 = MFMA32(lfrag(cur + koff[ds]), qf[ds], z0); z1 = MFMA32(lfrag(cur + 4096 + koff[ds]), qf[ds], z1); }
            if (t == td) {
                const float limf = (float)(qrel - 8 * half);
#pragma unroll
                for (int i = 0; i < 16; ++i) { const float o = (float)(16 * (i >> 3) + (i & 7)) + 0.5f;
                    z0[i] = fmaf(fminf(limf - o, 0.f), 1e30f, z0[i]); z1[i] = fmaf(fminf(limf - (o + 32.f), 0.f), 1e30f, z1[i]); }
            }
            f32x16 c0, c1;
#pragma unroll
            for (int i = 0; i < 16; ++i) {
                c0[i] = fmaxf(z0[i], 0.f) + flog2(1.f + fexp2(-fabsf(z0[i]))); c1[i] = fmaxf(z1[i], 0.f) + flog2(1.f + fexp2(-fabsf(z1[i]))); }
            float run[4];
#pragma unroll
            for (int s = 0; s < 2; ++s) { float a = 0.f, bb = 0.f;
#pragma unroll
                for (int i = 7; i >= 0; --i) { a += c0[8 * s + i]; c0[8 * s + i] = a; bb += c1[8 * s + i]; c1[8 * s + i] = bb; }
                run[s] = a; run[2 + s] = bb; }
            float off[4]; float after = carry;
#pragma unroll
            for (int q = 3; q >= 0; --q) { const float xr = xhalf(run[q]); off[q] = after + (half ? 0.f : xr); after += run[q] + xr; }
            carry = after;
#pragma unroll
            for (int i = 0; i < 16; ++i) { const int s = i >> 3; z0[i] = fexp2(z0[i] - (c0[i] + off[s])); z1[i] = fexp2(z1[i] - (c1[i] + off[2 + s])); }
            const bf16x8 pf0 = pack8(z0, 0), pf1 = pack8(z0, 1), pf2 = pack8(z1, 0), pf3 = pack8(z1, 1);
#pragma unroll
            for (int db = 0; db < 2; ++db) {
                O[db] = MFMA32(lfrag(cur + db * 4096 + voff[0]), pf0, O[db]); O[db] = MFMA32(lfrag(cur + db * 4096 + voff[1]), pf1, O[db]);
                O[db] = MFMA32(lfrag(cur + db * 4096 + voff[2]), pf2, O[db]); O[db] = MFMA32(lfrag(cur + db * 4096 + voff[3]), pf3, O[db]); }
            if (t == 0 || __all(carry > SB_STOP)) { done = true; if (lane == 0) done_it[wave] = k; }
        }
        if (t > 0) { LAS unsigned char* nb = buf + ((k + 1) & 1) * 16384; *(LAS u32x4*)(nb + tid * 16) = kreg; *(LAS u32x4*)(nb + 8192 + tid * 16) = vreg; }
        __syncthreads();
        bool all = true;
#pragma unroll
        for (int w = 0; w < 8; ++w) all = all && (done_it[w] <= k);
        if (all) break;
    }
    LAS unsigned char* xs = (LAS unsigned char*)(F.lds + 36864 + wave * 4096);
#pragma unroll
    for (int db = 0; db < 2; ++db)
#pragma unroll
        for (int g = 0; g < 4; ++g) { u32x2 w; w.x = cvtpk(O[db][4 * g], O[db][4 * g + 1]); w.y = cvtpk(O[db][4 * g + 2], O[db][4 * g + 3]);
            *(LAS u32x2*)(xs + r32 * 128 + (((4 * db + g) ^ (r32 & 7)) << 4) + 8 * half) = w; }
#pragma unroll
    for (int i = 0; i < 4; ++i) { const int row = (lane >> 3) + 8 * i, ch = lane & 7;
        const u32x4 t = *(const LAS u32x4*)(xs + row * 128 + ((ch ^ (row & 7)) << 4));
        *(GAS u32x4*)(OC + (size_t)(tokb + qw + row) * 512 + h * 64 + ch * 8) = t; }
    __syncthreads();
}

#ifdef PROBE_LAYER
constexpr int NSAMP = 96;
__device__ __forceinline__ float bfv(const bf16_t* p) { return __uint_as_float(((unsigned)*p) << 16); }
__device__ float blk_max(float v, float* red) { __syncthreads(); red[threadIdx.x] = v; __syncthreads(); for (int s = 256; s > 0; s >>= 1) { if ((int)threadIdx.x < s) red[threadIdx.x] = fmaxf(red[threadIdx.x], red[threadIdx.x + s]); __syncthreads(); } const float r = red[0]; __syncthreads(); return r; }
__global__ void __launch_bounds__(512) oracle_kernel(const unsigned char* ws, const float* rel_bias, const float* lamp, const float* subg, float lam_init) {
    __shared__ float sc[4096]; __shared__ unsigned char sel[4096]; __shared__ float red[512]; __shared__ float ssq[4];
    const int samp = blockIdx.x, tid = threadIdx.x;
    const int b = samp & 3, t = (samp * 1597 + 41) & 4095, tok = b * SEQ + t, ci = t >> 6, limit = 64 * (ci + 1);
    const bf16_t* PROJ = (const bf16_t*)(ws + WS_PROJ); const bf16_t* VT = (const bf16_t*)(ws + WS_VT); const float* WI = (const float*)(ws + WS_WI);
    unsigned* errw = (unsigned*)(ws + WS_CTL + 32768);
    {
        for (int s = tid; s < limit; s += 512) { float tot = 0.f;
            for (int h = 0; h < 4; ++h) { float d = 0.f; for (int k = 0; k < 64; ++k) d += bfv(PROJ + (size_t)tok * NP + C_QI + h * 64 + k) * bfv(PROJ + (size_t)(b * SEQ + s) * NP + C_KI + k);
                tot += WI[(size_t)tok * 4 + h] * fmaxf(d, 0.f); }
            sc[s] = tot + 0.0f; }
        __syncthreads();
        const int topk = limit < 256 ? limit : 256;
        for (int s = tid; s < limit; s += 512) { const float v = sc[s]; int rank = 0; for (int j = 0; j < limit; ++j) { const float u = sc[j]; rank += (u > v || (u == v && j < s)) ? 1 : 0; } sel[s] = rank < topk ? 1 : 0; }
        __syncthreads();
        const int h = tid >> 6, d = tid & 63;
        float mx = -INFINITY;
        for (int s = 0; s < limit; ++s) if (sel[s]) { float lg = 0.f; for (int k = 0; k < 64; ++k) lg += bfv(PROJ + (size_t)tok * NP + C_QA + h * 64 + k) * bfv(PROJ + (size_t)(b * SEQ + s) * NP + C_KA + h * 64 + k);
            lg += rel_bias[t5_bucket(s - t) * 12 + h] * LOG2E; mx = fmaxf(mx, lg); }
        float l = 0.f, o = 0.f;
        for (int s = 0; s < limit; ++s) if (sel[s]) { float lg = 0.f; for (int k = 0; k < 64; ++k) lg += bfv(PROJ + (size_t)tok * NP + C_QA + h * 64 + k) * bfv(PROJ + (size_t)(b * SEQ + s) * NP + C_KA + h * 64 + k);
            lg += rel_bias[t5_bucket(s - t) * 12 + h] * LOG2E; const float p = exp2f(lg - mx); l += p; o += p * bfv(VT + (size_t)(h * 64 + d) * VTP + b * SEQ + s); }
        o /= l;
        const float mine = bfv((const bf16_t*)(ws + WS_OA) + (size_t)tok * 512 + tid);
        const float md = blk_max(fabsf(o - mine), red), ma = blk_max(fabsf(o), red);
        if (tid == 0) atomicMax(errw + 0, __float_as_uint(md / fmaxf(ma, 1e-20f)));
    }
    {
        const int h = tid >> 7, e = tid & 127; float on0 = 0.f, on1 = 0.f;
        for (int m = 0; m < 2; ++m) {
            float mx = -INFINITY;
            for (int s = 0; s < limit; ++s) { float lg = 0.f; for (int k = 0; k < 64; ++k) lg += bfv(PROJ + (size_t)tok * NP + C_QB + h * 128 + m * 64 + k) * bfv(PROJ + (size_t)(b * SEQ + s) * NP + C_KB + h * 128 + m * 64 + k);
                lg += rel_bias[t5_bucket(s - t) * 12 + 8 + h] * LOG2E; mx = fmaxf(mx, lg); }
            float l = 0.f, o = 0.f;
            for (int s = 0; s < limit; ++s) { float lg = 0.f; for (int k = 0; k < 64; ++k) lg += bfv(PROJ + (size_t)tok * NP + C_QB + h * 128 + m * 64 + k) * bfv(PROJ + (size_t)(b * SEQ + s) * NP + C_KB + h * 128 + m * 64 + k);
                lg += rel_bias[t5_bucket(s - t) * 12 + 8 + h] * LOG2E; const float p = exp2f(lg - mx); l += p; o += p * bfv(VT + (size_t)(512 + h * 128 + e) * VTP + b * SEQ + s); }
            if (m == 0) on0 = o / l; else on1 = o / l;
        }
        float la = 0.f, lb = 0.f; for (int k = 0; k < 64; ++k) { la += lamp[k] * lamp[64 + k]; lb += lamp[128 + k] * lamp[192 + k]; }
        const float lam = expf(la) - expf(lb) + lam_init;
        float o = on0 - lam * on1;
        if (tid < 4) ssq[tid] = 0.f; __syncthreads(); atomicAdd(&ssq[h], o * o); __syncthreads();
        o = o * rsqrtf(ssq[h] / 128.f + 1e-5f) * subg[e] * (1.0f - lam_init);
        const float mine = bfv((const bf16_t*)(ws + WS_OB) + (size_t)tok * 512 + tid);
        const float md = blk_max(fabsf(o - mine), red), ma = blk_max(fabsf(o), red);
        if (tid == 0) atomicMax(errw + 1, __float_as_uint(md / fmaxf(ma, 1e-20f)));
    }
    {
        const int h = tid >> 6, d = tid & 63; float C = 0.f, o = 0.f;
        for (int s = t - 1; s >= 0; --s) { float z = 0.f; for (int k = 0; k < 64; ++k) z += bfv(PROJ + (size_t)tok * NP + C_QC + h * 64 + k) * bfv(PROJ + (size_t)(b * SEQ + s) * NP + C_KC + h * 64 + k);
            const float sp = fmaxf(z, 0.f) + log2f(1.f + exp2f(-fabsf(z))); C += sp; o += exp2f(z - C) * bfv(VT + (size_t)(1024 + h * 64 + d) * VTP + b * SEQ + s); }
        const float mine = bfv((const bf16_t*)(ws + WS_OC) + (size_t)tok * 512 + tid);
        const float md = blk_max(fabsf(o - mine), red), ma = blk_max(fabsf(o), red);
        if (tid == 0) atomicMax(errw + 2, __float_as_uint(md / fmaxf(ma, 1e-20f)));
    }
}
#ifndef PROBE_SEL
#define PROBE_SEL -1
#endif
__global__ void probe_out_kernel(const unsigned char* ws, float* out, int n) {
    const unsigned* errw = (const unsigned*)(ws + WS_CTL + 32768);
    float v;
    if (PROBE_SEL < 0) { int code = 0; for (int k = 0; k < 3; ++k) { const float e = __uint_as_float(errw[k]); if (!(e < 0.03f)) code |= 1 << k; } v = 20.f + 8.f * code; }
    else v = 20.f + 1e4f * __uint_as_float(errw[PROBE_SEL]);
    const float c = sqrtf(v);
    for (int i = blockIdx.x * blockDim.x + threadIdx.x; i < n; i += gridDim.x * blockDim.x) out[i] = c;
}
#endif

constexpr int LDS_BYTES = 155648;
constexpr int MISC_OFF = LDS_BYTES - 1024;
constexpr int NPH_LAYER = 13, NPHASES = 1 + 2 * NPH_LAYER;

#define IN(i) karg_in(i)
#define WSP(off) wsp(F.ws, (off))
#ifndef LBW
#define LBW 2
#endif
__global__ void __launch_bounds__(NTHREADS, LBW) fwd_kernel(Args args_unused) {
    extern __shared__ __attribute__((aligned(16))) unsigned char lds_raw[];
    Frame F;
    F.lds = (LAS unsigned char*)lds_raw;
    F.G = gridDim.x; F.bx = blockIdx.x; F.vcu = (F.bx % 8) * (F.G / 8) + F.bx / 8; F.ws = (unsigned char*)karg_in(22);
    unsigned* ctl = (unsigned*)(F.ws + WS_CTL);
    if (threadIdx.x < 4) ((LAS unsigned*)(F.lds + MISC_OFF))[threadIdx.x] = 0u;
    __syncthreads();
    const int lo = karg_int(46), hi = karg_int(47);
    const bool one_launch = (hi - lo) > 1;
    XcdBarrier bar; bar.bar = ctl + CW_BAR; bar.x = 0; bar.st = nullptr;
    if (one_launch) bar = xcd_barrier_post(ctl + CW_BAR, (volatile LAS unsigned*)(F.lds + MISC_OFF));
#ifndef ONLY_PH
#define ONLY_PH -1
#endif
#define PHEN(k) (ONLY_PH < 0 || ONLY_PH == (k))
#define RUN(id) (lo <= (id) && (id) < hi)
#define RUNK(k) (PHEN(k) && RUN(pb + (k)))
#ifndef ORD_P1
#define ORD_P1 0
#endif
#ifndef ORD_P7
#define ORD_P7 0
#endif
#ifndef ORD_P10
#define ORD_P10 0
#endif
#ifndef ORD_P11
#define ORD_P11 0
#endif
#ifndef DUP_PH
#define DUP_PH -1
#endif
#ifndef DUP_L
#define DUP_L -1
#endif
#define REP(k) for (int rep_ = 0; rep_ < (((DUP_PH) == (k) && (DUP_L < 0 || DUP_L == l_rep_)) ? 2 : 1); ++rep_)
#ifdef TIMER_PH
#ifndef TIMER_L
#define TIMER_L 0
#endif
#define SEAM(id) do { if ((id) + 1 < hi) xcd_barrier(bar); \
        if ((id) == 1 + NPH_LAYER * TIMER_L + TIMER_PH && blockIdx.x == 0 && threadIdx.x == 0) ctl[16] = (unsigned)wall_clock64() - ctl[17]; } while (0)
#define TSTART(k) do { if ((k) == TIMER_PH && l == TIMER_L && blockIdx.x == 0 && threadIdx.x == 0) ctl[17] = (unsigned)wall_clock64(); } while (0)
#else
#define SEAM(id) do { if ((id) + 1 < hi) xcd_barrier(bar); } while (0)
#define TSTART(k) do { } while (0)
#endif

    if (PHEN(100) && RUN(0)) { const int l_rep_ = 0; (void)l_rep_; REP(100) { p0_prologue(F); __syncthreads(); } SEAM(0); }

    for (int l = 0; l < DEPTH; ++l) {
        const int pb = 1 + NPH_LAYER * l; const int l_rep_ = l; (void)l_rep_;
#define MODL(k) ((const float*)WSP(WS_MOD) + (size_t)l * 4 * 6144 + (k) * D)
#define XCUR() ((l == 0) ? IN(0) : (const float*)IN(21))
#define XRES() ((float*)IN(21))
        if (RUNK(0)) { TSTART(0); norm_phase<false>(F, XCUR(), IN(4) + l * D, MODL(0), MODL(1), (bf16_t*)WSP(WS_XN), nullptr, nullptr); SEAM(pb + 0); }
        if (RUNK(1)) { TSTART(1); REP(1) {
#ifdef STAGGER_US10
            {
                const unsigned long long t0_ = __builtin_amdgcn_s_memrealtime(); const unsigned long long dl_ = (unsigned long long)((F.bx >> 3) & 31) * STAGGER_US10 * 10ull;
                while (__builtin_amdgcn_s_memrealtime() - t0_ < dl_) __builtin_amdgcn_s_sleep(8);
            }
#endif
#ifdef INPROJ_ONLY
            if (!(rep_ == 0 && INPROJ_ONLY == 2))
#endif
            { pg8::Gemm g{D, D, D}; TileSched S; S.init(WS_XN, WS_WIN + (size_t)l * 13 * MiB, T, NPROJ, D, D, F.G, F.bx); S.ord = ORD_P1;
#ifdef INPROJ_ABL
#if INPROJ_ABL == 2
              if (rep_ == 0) { EpiBf16 E0{(bf16_t*)WSP(WS_PROJ), NP}; fill_units(F.lds, S); pg8::gemm_phase(F.lds, (const char*)F.ws, g, E0); } else
#elif INPROJ_ABL == 3
              if (rep_ == 0) { EpiBlocked E0{(bf16_t*)WSP(WS_PROJ)}; fill_units(F.lds, S); pg8::gemm_phase(F.lds, (const char*)F.ws, g, E0); xcd_barrier(bar); } else
#else
              if (rep_ == 0) { EpiLinear E0{(bf16_t*)WSP(WS_PROJ)}; fill_units(F.lds, S); pg8::gemm_phase(F.lds, (const char*)F.ws, g, E0); } else
#endif
#endif
              { EpiProj E{(bf16_t*)WSP(WS_PROJ), (float*)WSP(WS_WI), F.lds}; fill_units(F.lds, S); pg8::gemm_phase(F.lds, (const char*)F.ws, g, E); } }
#ifdef INPROJ_ONLY
            if (!(rep_ == 0 && INPROJ_ONLY == 1))
#endif
            { pg8::Gemm g{D, D, D}; TileSched S; S.init(WS_WV + (size_t)l * 3 * MiB, WS_XN, 1536, T, D, D, F.G, (F.bx + 128) & 255);
              EpiBf16 E{(bf16_t*)WSP(WS_VT), VTP, F.lds}; fill_units(F.lds, S); pg8::gemm_phase(F.lds, (const char*)F.ws, g, E); }
            }
            SEAM(pb + 1);
        }
        if (RUNK(2)) { TSTART(2); REP(2) {
            const int c = F.vcu, b = c >> 6, m = c & 63;
            const bf16_t* PROJ = (const bf16_t*)WSP(WS_PROJ); const float* WI = (const float*)WSP(WS_WI); unsigned long long* MASK = (unsigned long long*)WSP(WS_MASK);
            topk_wg(F, b, m, PROJ, WI, MASK);
            }
        }
        if (RUNK(3)) { TSTART(3); REP(3) {
            const int c = F.vcu, bh = c >> 4, s = c & 15; const float lam_init = 0.8f - 0.6f * __expf(-0.3f * (float)l);
            const bool hiw = (__builtin_amdgcn_readfirstlane((int)threadIdx.x >> 6) & 1) != 0;
            for (int k = 0; k < 2; ++k) { if (!hiw) attn_unit<1, 0>(F, bh >> 2, bh & 3, k == 0 ? s : 31 - s, (const bf16_t*)WSP(WS_PROJ), (const bf16_t*)WSP(WS_VT), nullptr, (bf16_t*)WSP(WS_OB), IN(9), IN(10) + l * 256, IN(11) + l * 128, lam_init); else attn_unit<1, 1>(F, bh >> 2, bh & 3, k == 0 ? s : 31 - s, (const bf16_t*)WSP(WS_PROJ), (const bf16_t*)WSP(WS_VT), nullptr, (bf16_t*)WSP(WS_OB), IN(9), IN(10) + l * 256, IN(11) + l * 128, lam_init); }
            }
        }
        if (RUNK(4)) { TSTART(4); REP(4) {
            const int c = F.vcu, bh = c >> 3, s = c & 7;
            for (int k = 0; k < 2; ++k) sb_unit(F, bh >> 3, bh & 7, k == 0 ? s : 15 - s, (const bf16_t*)WSP(WS_PROJ), (const bf16_t*)WSP(WS_VT), (bf16_t*)WSP(WS_OC));
            }
            SEAM(pb + 4);
        }
        if (RUNK(5)) { TSTART(5); REP(5) {
            const int c = F.vcu, bh = c >> 3, s = c & 7;
            const bool hiw = (__builtin_amdgcn_readfirstlane((int)threadIdx.x >> 6) & 1) != 0;
#ifdef ATP_PROBE
                        for (int k = 0; k < 2; ++k) { if (!hiw) attn_unit<0, 0, ATP_PROBE>(F, bh >> 3, bh & 7, k == 0 ? s : 15 - s, (const bf16_t*)WSP(WS_PROJ), (const bf16_t*)WSP(WS_VT), (const unsigned long long*)WSP(WS_MASK), (bf16_t*)WSP(WS_OA), IN(9), nullptr, nullptr, 0.f); else attn_unit<0, 1, ATP_PROBE>(F, bh >> 3, bh & 7, k == 0 ? s : 15 - s, (const bf16_t*)WSP(WS_PROJ), (const bf16_t*)WSP(WS_VT), (const unsigned long long*)WSP(WS_MASK), (bf16_t*)WSP(WS_OA), IN(9), nullptr, nullptr, 0.f); }
#endif
            for (int k = 0; k < 2; ++k) { if (!hiw) attn_unit<0, 0>(F, bh >> 3, bh & 7, k == 0 ? s : 15 - s, (const bf16_t*)WSP(WS_PROJ), (const bf16_t*)WSP(WS_VT), (const unsigned long long*)WSP(WS_MASK), (bf16_t*)WSP(WS_OA), IN(9), nullptr, nullptr, 0.f); else attn_unit<0, 1>(F, bh >> 3, bh & 7, k == 0 ? s : 15 - s, (const bf16_t*)WSP(WS_PROJ), (const bf16_t*)WSP(WS_VT), (const unsigned long long*)WSP(WS_MASK), (bf16_t*)WSP(WS_OA), IN(9), nullptr, nullptr, 0.f); }

            }
            SEAM(pb + 5);
        }
        if (RUNK(6)) { TSTART(6);
            pg8::Gemm g{512, 512, 512}; BranchSched S; S.B = (unsigned)(WS_WBR + (size_t)l * 3 * MiB); S.c = F.bx;
            EpiBranch E{(const bf16_t*)WSP(WS_PROJ) + C_GATE, (bf16_t*)WSP(WS_MERGED), F.lds}; fill_units(F.lds, S); pg8::gemm_phase(F.lds, (const char*)F.ws, g, E);
            SEAM(pb + 6);
        }
        if (RUNK(7)) { TSTART(7);
            pg8::Gemm g{D, D, D}; TileSched S; S.init(WS_MERGED, WS_WOUT + (size_t)l * 2 * MiB, T, D, D, D, F.G, F.bx); S.ord = ORD_P7;
            EpiResid E{XCUR(), XRES(), MODL(2), F.lds}; fill_units(F.lds, S); pg8::gemm_phase(F.lds, (const char*)F.ws, g, E);
            SEAM(pb + 7);
        }
        if (l == 0) {
            if (RUNK(8)) { TSTART(8); norm_phase<false>(F, XRES(), IN(5) + l * D, MODL(3), MODL(4), (bf16_t*)WSP(WS_XN), nullptr, nullptr); SEAM(pb + 8); }
            if (RUNK(10)) { TSTART(10); REP(10) {
                pg8::Gemm g{D, D, D}; TileSched S; S.init(WS_XN, WS_W13, T, 2 * DFF, D, D, F.G, F.bx); S.ord = ORD_P10;
                EpiSwiGLU E{(bf16_t*)WSP(WS_HID), DFF}; fill_units(F.lds, S); pg8::gemm_phase(F.lds, (const char*)F.ws, g, E);
                }
                SEAM(pb + 10);
            }
            if (RUNK(11)) { TSTART(11); REP(111) {
                pg8::Gemm g{DFF, DFF, DFF}; TileSched S; S.init(WS_HID, WS_W2, T, D, DFF, DFF, F.G, F.bx); S.ord = ORD_P11;
                EpiResid E{XRES(), XRES(), MODL(5), F.lds}; fill_units(F.lds, S); pg8::gemm_phase<EpiResid, false, true>(F.lds, (const char*)F.ws, g, E);
                }
                SEAM(pb + 11);
            }
        } else {
            if (RUNK(8)) { TSTART(8); norm_phase<true>(F, XRES(), IN(5) + l * D, MODL(3), MODL(4), (bf16_t*)WSP(WS_XN), IN(15), IN(16)); SEAM(pb + 8); }
            if (RUNK(9)) { TSTART(9); moe_gather_phase(F, (const bf16_t*)WSP(WS_XN), (bf16_t*)WSP(WS_XP)); SEAM(pb + 9); }
            if (RUNK(10)) { TSTART(10); REP(10) {
                pg8::Gemm g{D, D, D}; MoeSched S{(unsigned)WS_XP, (unsigned)WS_MW13, (const int*)WSP(WS_TILETAB), 256u * D * 2, 256u * D * 2, 2u * DFFE * D * 2, 2 * DFFE / 256, F.G, F.bx, 1, 0u, 0u};
#ifdef MOE_E0
                if (DUP_PH == 10 && rep_ == 0) S.estep = 0u;
#endif
#ifdef MOE_A0
                if (DUP_PH == 10 && rep_ == 0) S.astep = 0u;
#endif
                EpiSwiGLU E{(bf16_t*)WSP(WS_HID), DFFE}; fill_units(F.lds, S); pg8::gemm_phase(F.lds, (const char*)F.ws, g, E);
                }
                SEAM(pb + 10);
            }
            if (RUNK(11)) { TSTART(11); REP(11) {
                pg8::Gemm g{DFFE / 2, DFFE, DFFE}; MoeSched S{(unsigned)WS_HID, (unsigned)WS_MW2, (const int*)WSP(WS_TILETAB), 256u * DFFE * 2, 256u * DFFE * 2, (unsigned)D * DFFE * 2, D / 256, F.G, F.bx, 2, (unsigned)DFFE, (unsigned)(DFFE / 64) * 16384u};
                EpiBf16Split E{(bf16_t*)WSP(WS_XP), (bf16_t*)WSP(WS_MW13), D, F.lds}; fill_units(F.lds, S); pg8::gemm_phase<EpiBf16Split, false, true>(F.lds, (const char*)F.ws, g, E);
                }
                SEAM(pb + 11);
            }
            if (RUNK(12)) { TSTART(12); final_phase(F, XRES(), (const bf16_t*)WSP(WS_XP), (const bf16_t*)WSP(WS_MW13), MODL(5), IN(20)); }
        }
    }
#ifdef TIMER_PH
    {
        __syncthreads();
        const float us = (float)__hip_atomic_load(ctl + 16, __ATOMIC_RELAXED, __HIP_MEMORY_SCOPE_AGENT) * 0.01f; const float cst = logf(fmaxf(us, 1.0f));
        float* o = (float*)IN(21) + (size_t)blockIdx.x * 64 * D;
        for (int i = threadIdx.x; i < 64 * D; i += NTHREADS) o[i] = cst;
    }
#endif
#undef RUN
#undef SEAM
}

#include <cmath>
#ifndef N_LAUNCH_MODE
#define N_LAUNCH_MODE 1
#endif
extern "C" void kernel_launch(void* const* d_in, const int* in_sizes, int n_in, void* d_out, int out_size, void* d_ws, size_t ws_size, hipStream_t stream) {
    static int grid = 0;
    if (grid == 0) {
        if (n_in != 21 || in_sizes[0] != T * D || out_size != T * D || ws_size < WS_END) { fprintf(stderr, "kernel_launch: unexpected shapes / workspace (%d inputs, ws %zu < %zu)\n", n_in, ws_size, (size_t)WS_END); grid = -1; return; }
        int dev = 0, cus = 0, per_cu = 0;
        if (hipGetDevice(&dev) != hipSuccess || hipDeviceGetAttribute(&cus, hipDeviceAttributeMultiprocessorCount, dev) != hipSuccess) { grid = -1; return; }
        if (hipFuncSetAttribute((const void*)fwd_kernel, hipFuncAttributeMaxDynamicSharedMemorySize, LDS_BYTES) != hipSuccess) { fprintf(stderr, "kernel_launch: cannot get %d bytes of LDS\n", LDS_BYTES); grid = -1; return; }
        if (hipOccupancyMaxActiveBlocksPerMultiprocessor(&per_cu, (const void*)fwd_kernel, NTHREADS, LDS_BYTES) != hipSuccess || per_cu < 1) { fprintf(stderr, "kernel_launch: occupancy query says %d\n", per_cu); }
        (void)hipGetLastError();
        if (cus != 256) { fprintf(stderr, "kernel_launch: built for 256 CUs, found %d\n", cus); grid = -1; return; }
        grid = 256;
    }
    if (grid < 0) return;
    (void)hipMemsetAsync((char*)d_ws + WS_CTL, 0, CTL_ZERO_BYTES, stream);
    Args a{};
    for (int i = 0; i < 21; ++i) a.in[i] = (const float*)d_in[i];
    a.out = (float*)d_out; a.ws = (unsigned char*)d_ws;
#if defined(PROBE_LAYER)
    a.ph_lo = 0; a.ph_hi = 1 + NPH_LAYER * PROBE_LAYER + 6;
    hipLaunchKernelGGL(fwd_kernel, dim3(grid), dim3(NTHREADS), LDS_BYTES, stream, a);
    hipLaunchKernelGGL(oracle_kernel, dim3(NSAMP), dim3(512), 0, stream, (const unsigned char*)d_ws, (const float*)d_in[9], (const float*)d_in[10] + PROBE_LAYER * 256, (const float*)d_in[11] + PROBE_LAYER * 128, 0.8f - 0.6f * expf(-0.3f * (float)PROBE_LAYER));
    hipLaunchKernelGGL(probe_out_kernel, dim3(1024), dim3(256), 0, stream, (const unsigned char*)d_ws, (float*)d_out, out_size);
#elif N_LAUNCH_MODE == 1
    a.ph_lo = 0; a.ph_hi = NPHASES;
    hipLaunchKernelGGL(fwd_kernel, dim3(grid), dim3(NTHREADS), LDS_BYTES, stream, a);
#else
    for (int p = 0; p < NPHASES; ++p) {
        if (p == 1 + 9 || p == 1 + 12) continue;
        a.ph_lo = p; a.ph_hi = p + 1;
        hipLaunchKernelGGL(fwd_kernel, dim3(grid), dim3(NTHREADS), LDS_BYTES, stream, a);
    }
#endif
}
```
